# Optimizing an MI355X kernel written in HIP

```python
import math
import jax, jax.numpy as jnp
from jax import lax
import numpy as np

D_MODEL = 2048
BATCH = 1
SEQ = 8192
DEPTH = 1

HEAD_DIM = 64
HEADS_PER_GROUP = 8
DILATED_GROUPS = ((128, 1), (512, 4), (2048, 16))
N_DGROUPS = len(DILATED_GROUPS)
N_ATTN_HEADS = N_DGROUPS * HEADS_PER_GROUP
ATTN_QKV = N_ATTN_HEADS * HEAD_DIM
ATTN_OUT = HEADS_PER_GROUP * HEAD_DIM
ATTN_BLOCK = 128

SSM_WIDTH = D_MODEL // 2
SSM_CH_PER_GROUP = 16
SSM_GROUPS = SSM_WIDTH // SSM_CH_PER_GROUP
SSM_STATE = 64

N_EXPERT_GROUPS = 4
EXPERTS_PER_GROUP = 8
N_EXPERTS = N_EXPERT_GROUPS * EXPERTS_PER_GROUP
TOP_K_IN_GROUP = 2
EXPERT_FF = D_MODEL // 4
MOE_BLOCK = 128

NORM_EPS = 1e-6
IN_COLS = 3 * ATTN_QKV + SSM_WIDTH + 2 * D_MODEL

kernel_name = "hybrid_dilated_attn_s5_hmoe_block"


def rms_norm(x, gain):
    xf = x.astype(jnp.float32)
    xf = xf * lax.rsqrt(jnp.mean(xf * xf, axis=-1, keepdims=True) + NORM_EPS)
    return (xf * gain.astype(jnp.float32)).astype(x.dtype)


def alibi_slopes(n_heads):
    return jnp.asarray([2.0 ** (-8.0 * (j + 1) / n_heads) for j in range(n_heads)], jnp.float32)


def dilated_window_attention(q, k, v, window, dilation, slopes):
    B_, S, H, Dh = q.shape
    L = ATTN_BLOCK
    n_back = window // dilation
    span = dilation * L
    Sp = -(-S // span) * span
    NB = Sp // span

    def to_blocks(t):
        t = jnp.pad(t, ((0, 0), (0, Sp - S), (0, 0), (0, 0)))
        t = t.reshape(B_, Sp // dilation, dilation, H, Dh).transpose(0, 2, 1, 3, 4)
        return t.reshape(B_, dilation, NB, L, H, Dh)

    def with_prev(t):
        prev = jnp.pad(t, ((0, 0), (0, 0), (1, 0), (0, 0), (0, 0), (0, 0)))[:, :, :-1]
        return jnp.concatenate([prev, t], axis=3)

    def from_blocks(t):
        tail = t.shape[4:]
        t = t.reshape((B_, dilation, Sp // dilation) + tail)
        t = jnp.swapaxes(t, 1, 2).reshape((B_, Sp) + tail)
        return t[:, :S]

    qb, kb, vb = to_blocks(q), to_blocks(k), to_blocks(v)
    kk, vv = with_prev(kb), with_prev(vb)

    qi = jnp.arange(L)[:, None]
    kj = jnp.arange(2 * L)[None, :]
    steps = qi + L - kj
    band = (steps >= 0) & (steps <= n_back)
    first_block = (jnp.arange(NB) == 0)[:, None, None]
    valid = band[None] & ~(first_block & (kj < L)[None])

    s = jnp.einsum('brnqhd,brnkhd->brnhqk', qb, kk).astype(jnp.float32) * (HEAD_DIM ** -0.5)
    bias = -slopes[:, None, None] * (dilation * steps).astype(jnp.float32)[None]
    s = s + bias[None, None, None]
    s = jnp.where(valid[None, None, :, None], s, -jnp.inf)
    m = jnp.max(s, axis=-1, keepdims=True)
    p = jnp.exp(s - m)
    denom = jnp.sum(p, axis=-1)
    o = jnp.einsum('brnhqk,brnkhd->brnqhd', p.astype(vv.dtype), vv).astype(jnp.float32)
    denom_t = jnp.swapaxes(denom, 3, 4)
    o = (o / denom_t[..., None]).astype(q.dtype)
    lse = jnp.swapaxes(m[..., 0] + jnp.log(denom), 3, 4)
    return from_blocks(o), from_blocks(lse)


def dilated_mixture_attention(q, k, v, slopes):
    B_, S, _ = q.shape

    def heads(t):
        return t.reshape(B_, S, N_DGROUPS, HEADS_PER_GROUP, HEAD_DIM)

    qh, kh, vh = heads(q), heads(k), heads(v)
    outs, lses = [], []
    for g, (window, dilation) in enumerate(DILATED_GROUPS):
        o, l = dilated_window_attention(qh[:, :, g], kh[:, :, g], vh[:, :, g], window, dilation, slopes)
        outs.append(o)
        lses.append(l)
    w = jax.nn.softmax(jnp.stack(lses, axis=2), axis=2)
    o = jnp.einsum('bsgh,bsghd->bshd', w.astype(q.dtype), jnp.stack(outs, axis=2))
    return o.reshape(B_, S, ATTN_OUT)


def s5_ssm(u, a_re, a_im, log_step, b_re, b_im, c_re, c_im, d_skip):
    f32 = jnp.float32
    u = u.astype(f32)
    a_re, a_im = a_re.astype(f32), a_im.astype(f32)
    B_, S, _ = u.shape
    ug = u.reshape(B_, S, SSM_GROUPS, SSM_CH_PER_GROUP)
    step = jnp.exp(log_step.astype(f32))[:, None]
    mag = jnp.exp(a_re * step)
    ang = a_im * step
    abar_re, abar_im = mag * jnp.cos(ang), mag * jnp.sin(ang)
    nr, ni = abar_re - 1.0, abar_im
    den = a_re * a_re + a_im * a_im
    f_re = (nr * a_re + ni * a_im) / den
    f_im = (ni * a_re - nr * a_im) / den
    b_re, b_im = b_re.astype(f32), b_im.astype(f32)
    bbar_re = f_re[..., None] * b_re - f_im[..., None] * b_im
    bbar_im = f_re[..., None] * b_im + f_im[..., None] * b_re
    bu_re = jnp.einsum('gph,bsgh->bsgp', bbar_re, ug)
    bu_im = jnp.einsum('gph,bsgh->bsgp', bbar_im, ug)
    ar = jnp.broadcast_to(abar_re, bu_re.shape)
    ai = jnp.broadcast_to(abar_im, bu_re.shape)

    def combine(e1, e2):
        a1r, a1i, b1r, b1i = e1
        a2r, a2i, b2r, b2i = e2
        return (a2r * a1r - a2i * a1i, a2r * a1i + a2i * a1r,
                a2r * b1r - a2i * b1i + b2r, a2r * b1i + a2i * b1r + b2i)

    _, _, xr, xi = lax.associative_scan(combine, (ar, ai, bu_re, bu_im), axis=1)
    y = (jnp.einsum('ghp,bsgp->bsgh', c_re.astype(f32), xr)
         - jnp.einsum('ghp,bsgp->bsgh', c_im.astype(f32), xi))
    return y.reshape(B_, S, SSM_WIDTH) + d_skip.astype(f32) * u


def hierarchical_moe(h, w_rg, b_rg, w_re, b_re, w_gate, w_up, w_down):
    B_, S, D = h.shape
    xt = h.reshape(-1, D)
    T = xt.shape[0]
    K = TOP_K_IN_GROUP
    g_logits = (xt @ w_rg).astype(jnp.float32) + b_rg.astype(jnp.float32)
    g_probs = jax.nn.softmax(g_logits, axis=-1)
    g_p, g_idx = lax.top_k(g_probs, 1)
    e_logits = ((xt @ w_re).astype(jnp.float32) + b_re.astype(jnp.float32)).reshape(T, N_EXPERT_GROUPS, EXPERTS_PER_GROUP)
    in_group = jnp.take_along_axis(e_logits, g_idx[:, :, None], axis=1)[:, 0]
    top_l, top_j = lax.top_k(in_group, K)
    weights = g_p * jax.nn.softmax(top_l, axis=-1)
    expert_idx = g_idx * EXPERTS_PER_GROUP + top_j

    A = T * K
    flat_e = expert_idx.reshape(A)
    flat_tok = jnp.repeat(jnp.arange(T, dtype=jnp.int32), K)
    order = jnp.argsort(flat_e)
    sorted_e = flat_e[order]
    counts = jnp.bincount(flat_e, length=N_EXPERTS)
    padded = (counts + MOE_BLOCK - 1) // MOE_BLOCK * MOE_BLOCK
    pad_end = jnp.cumsum(padded)
    pad_start = pad_end - padded
    start = jnp.cumsum(counts) - counts
    dest_sorted = pad_start[sorted_e] + jnp.arange(A) - start[sorted_e]
    dest = jnp.zeros((A,), jnp.int32).at[order].set(dest_sorted.astype(jnp.int32))
    n_rows = (-(-A // MOE_BLOCK) + N_EXPERTS) * MOE_BLOCK
    n_blocks = n_rows // MOE_BLOCK
    row_token = jnp.zeros((n_rows,), jnp.int32).at[dest].set(flat_tok)
    row_valid = jnp.zeros((n_rows,), bool).at[dest].set(True)
    block_expert = jnp.minimum(
        jnp.searchsorted(pad_end, jnp.arange(n_blocks) * MOE_BLOCK, side='right'), N_EXPERTS - 1)
    xs = jnp.where(row_valid[:, None], xt[row_token], 0).reshape(n_blocks, MOE_BLOCK, D)

    def expert_block(args):
        xb, e = args
        hid = jax.nn.silu(xb @ w_gate[e]) * (xb @ w_up[e])
        return hid @ w_down[e]

    ys = lax.map(expert_block, (xs, block_expert)).reshape(n_rows, D)
    y_assign = ys[dest].reshape(T, K, D)
    out = jnp.einsum('tk,tkd->td', weights.astype(y_assign.dtype), y_assign)
    return out.reshape(B_, S, D)


def setup_inputs(seed: int = 0) -> dict:
    key = jax.random.key(seed)
    ks = jax.random.split(key, 28)
    f32 = jnp.float32
    D, L_, G, P, H = D_MODEL, DEPTH, SSM_GROUPS, SSM_STATE, SSM_CH_PER_GROUP

    def nrm(k, shape, scale):
        return jax.random.normal(k, shape, f32) * scale

    return {
        "x": nrm(ks[0], (BATCH, SEQ, D), 1.0),
        "norm_mix": 1.0 + nrm(ks[1], (L_, D), 0.01),
        "w_in": nrm(ks[2], (L_, D, IN_COLS), D ** -0.5),
        "b_gate": nrm(ks[3], (L_, 2 * D), 0.1),
        "ssm_a_re": -0.5 + nrm(ks[4], (L_, G, P), 0.01),
        "ssm_a_im": math.pi * jnp.arange(P, dtype=f32) + nrm(ks[5], (L_, G, P), 0.01),
        "ssm_log_step": jax.random.uniform(ks[6], (L_, G), f32, math.log(1e-3), math.log(1e-1)),
        "ssm_b_re": nrm(ks[7], (L_, G, P, H), (2 * H) ** -0.5),
        "ssm_b_im": nrm(ks[8], (L_, G, P, H), (2 * H) ** -0.5),
        "ssm_c_re": nrm(ks[9], (L_, G, H, P), P ** -0.5),
        "ssm_c_im": nrm(ks[10], (L_, G, H, P), P ** -0.5),
        "ssm_d": nrm(ks[11], (L_, SSM_WIDTH), 1.0),
        "w_glu": nrm(ks[12], (L_, SSM_WIDTH, SSM_WIDTH), SSM_WIDTH ** -0.5),
        "b_glu": nrm(ks[13], (L_, SSM_WIDTH), 0.01),
        "w_up_attn": nrm(ks[14], (L_, ATTN_OUT, D), ATTN_OUT ** -0.5),
        "w_up_ssm": nrm(ks[15], (L_, SSM_WIDTH, D), SSM_WIDTH ** -0.5),
        "w_out": nrm(ks[16], (L_, D, D), D ** -0.5),
        "norm_ffn": 1.0 + nrm(ks[17], (L_, D), 0.01),
        "w_router_group": nrm(ks[18], (L_, D, N_EXPERT_GROUPS), D ** -0.5),
        "b_router_group": nrm(ks[19], (L_, N_EXPERT_GROUPS), 0.01),
        "w_router_expert": nrm(ks[20], (L_, D, N_EXPERTS), D ** -0.5),
        "b_router_expert": nrm(ks[21], (L_, N_EXPERTS), 0.01),
        "w_expert_gate": nrm(ks[22], (L_, N_EXPERTS, D, EXPERT_FF), D ** -0.5),
        "w_expert_up": nrm(ks[23], (L_, N_EXPERTS, D, EXPERT_FF), D ** -0.5),
        "w_expert_down": nrm(ks[24], (L_, N_EXPERTS, EXPERT_FF, D), EXPERT_FF ** -0.5),
        "norm_final": 1.0 + nrm(ks[25], (D,), 0.01),
    }


def reference(x, norm_mix, w_in, b_gate, ssm_a_re, ssm_a_im, ssm_log_step, ssm_b_re, ssm_b_im,
              ssm_c_re, ssm_c_im, ssm_d, w_glu, b_glu, w_up_attn, w_up_ssm, w_out, norm_ffn,
              w_router_group, b_router_group, w_router_expert, b_router_expert,
              w_expert_gate, w_expert_up, w_expert_down, norm_final):
    slopes = alibi_slopes(HEADS_PER_GROUP)
    splits = [ATTN_QKV, 2 * ATTN_QKV, 3 * ATTN_QKV, 3 * ATTN_QKV + SSM_WIDTH]
    for layer in range(DEPTH):
        h = rms_norm(x, norm_mix[layer])
        proj = h @ w_in[layer]
        q, k, v, u, gate_logits = jnp.split(proj, splits, axis=-1)
        attn = dilated_mixture_attention(q, k, v, slopes)
        y = s5_ssm(u, ssm_a_re[layer], ssm_a_im[layer], ssm_log_step[layer], ssm_b_re[layer],
                   ssm_b_im[layer], ssm_c_re[layer], ssm_c_im[layer], ssm_d[layer])
        yg = jax.nn.gelu(y)
        ssm = (yg * jax.nn.sigmoid(yg @ w_glu[layer].astype(jnp.float32) + b_glu[layer].astype(jnp.float32))).astype(x.dtype)
        gates = jax.nn.sigmoid(gate_logits + b_gate[layer])
        g_attn, g_ssm = jnp.split(gates, 2, axis=-1)
        merged = g_attn * (attn @ w_up_attn[layer]) + g_ssm * (ssm @ w_up_ssm[layer])
        x = x + merged @ w_out[layer]
        h = rms_norm(x, norm_ffn[layer])
        x = x + hierarchical_moe(h, w_router_group[layer], b_router_group[layer], w_router_expert[layer],
                                 b_router_expert[layer], w_expert_gate[layer], w_expert_up[layer],
                                 w_expert_down[layer])
    return rms_norm(x, norm_final)
```

```cpp
#include <hip/hip_runtime.h>
#include <cstdio>
#include <cstdint>

#ifndef MK_N_LAUNCHES
#define MK_N_LAUNCHES 1
#endif

#ifndef DBG
#define DBG 0
#endif
#define LAS __attribute__((address_space(3)))
#define GAS __attribute__((address_space(1)))
typedef _Float16 h16;
typedef _Float16 h16x8 __attribute__((ext_vector_type(8)));
typedef _Float16 h16x4 __attribute__((ext_vector_type(4)));
typedef _Float16 h16x2 __attribute__((ext_vector_type(2)));
typedef float f32x2 __attribute__((ext_vector_type(2)));
typedef float f32x4 __attribute__((ext_vector_type(4)));
typedef float f32x16 __attribute__((ext_vector_type(16)));
typedef unsigned u32x2 __attribute__((ext_vector_type(2)));
typedef unsigned u32x4 __attribute__((ext_vector_type(4)));
typedef short s16x4 __attribute__((ext_vector_type(4)));

constexpr int T = 8192, D = 2048;
constexpr int QKV = 1536, SSMW = 1024, INC = 9728;
constexpr int COL_K = 1536, COL_V = 3072, COL_U = 4608, COL_G = 5632;
constexpr int NE = 32, FF = 512;
constexpr float EPS = 1e-6f;
constexpr float LOG2E = 1.4426950408889634f, LN2 = 0.6931471805599453f;

constexpr size_t MiB = 1u << 20;
constexpr size_t WS_CTL = 0, CTL_ZERO_BYTES = 64 * 1024;
constexpr size_t WS_AB = 1 * MiB;
constexpr size_t WS_BB = WS_AB + 256 * 1024;
constexpr size_t WS_CT = WS_BB + 256 * 1024;
constexpr size_t WS_LSE = 2 * MiB;
constexpr size_t WS_ROUTI = 3 * MiB;
constexpr size_t WS_ROUTF = WS_ROUTI + 128 * 1024;
constexpr size_t WS_TOKROW = WS_ROUTF + 128 * 1024;
constexpr size_t WS_TILEE = WS_TOKROW + 64 * 1024;
constexpr size_t WS_WR = 4 * MiB;
constexpr size_t WS_S = 8 * MiB;
constexpr size_t WS_WIN = 12 * MiB;
constexpr size_t WS_H = 50 * MiB;
constexpr size_t WS_X1 = 12 * MiB;
constexpr size_t WS_WGLU = 82 * MiB;
constexpr size_t WS_WUP = 84 * MiB;
constexpr size_t WS_WOUT = 90 * MiB;
constexpr size_t WS_WGU = 98 * MiB;
constexpr size_t WS_WDN = 226 * MiB;
constexpr size_t WS_PROJ = 290 * MiB;
constexpr size_t WS_OG = 442 * MiB;
constexpr size_t WS_YG = 466 * MiB;
constexpr size_t WS_ACAT = 482 * MiB;
constexpr size_t WS_MERGED = 442 * MiB;
constexpr size_t WS_XS = 290 * MiB;
constexpr size_t WS_HID = 386 * MiB;
constexpr size_t WS_Y = 410 * MiB;
constexpr size_t WS_END = 506 * MiB;
constexpr int MAXTILES = 96;
constexpr int CW_BAR = 4096;
constexpr int CW_CNT = 8192;

namespace pg8 {
constexpr int BM = 256, BK = 64, HALF = 128, HTB = HALF * BK * 2, STAGE_BYTES = 8 * HTB, NXCD = 8, WGM = 8;
__host__ __device__ __forceinline__ int lds_byte(int r, int c) { const int st = (r >> 4) * 2 + (c >> 5), rr = r & 15, cc = c & 31, ob = rr * 64 + cc * 2; return st * 1024 + (ob ^ (((ob >> 9) & 1) << 5)); }
__host__ __device__ __forceinline__ void stage_rc(int b, int& R, int& C) { const int st = b / 1024, sb = b % 1024, swz = sb ^ (((sb >> 9) & 1) << 5); R = (st >> 1) * 16 + swz / 64; C = (st & 1) * 32 + (swz % 64) / 2; }
__host__ __device__ __forceinline__ int perm32(int rho) { const int n = rho >> 4, i = rho & 15; return 8 * (i >> 2) + 4 * n + (i & 3); }

struct Unit { int pm, pn; size_t boff; };
struct Gemm { const h16* A; const h16* Bt; int K; size_t b_hstep; };

struct StaticOrder {
    int nM, nN, nwg, G, c, K;
    __device__ void init(int M, int N, int K_, int G_, int c_) { nM = M / BM; nN = N / BM; nwg = nM * nN; G = G_; c = c_; K = K_; }
    __device__ bool next(int i, Unit& u) const {
        const long L = (long)i * G + c; if (L >= nwg) return false;
        int wgid = (int)L; { const int q = nwg / NXCD, r = nwg % NXCD, xcd = wgid % NXCD, off = wgid / NXCD; wgid = (xcd < r ? xcd * (q + 1) : r * (q + 1) + (xcd - r) * q) + off; }
        const int nig = WGM * nN, gid = wgid / nig, fm = gid * WGM, gsz = (nM - fm) < WGM ? (nM - fm) : WGM;
        u.pm = fm + ((wgid % nig) % gsz); u.pn = (wgid % nig) / gsz; u.boff = (size_t)u.pn * BM * K * 2; return true;
    }
};
struct ExpertOrder {
    const int* tile_e; int NT, G, c; size_t e_bytes, pn_bytes;
    __device__ bool next(int i, Unit& u) const {
        const int MT = (int)__hip_atomic_load((unsigned*)tile_e + 127, __ATOMIC_RELAXED, __HIP_MEMORY_SCOPE_AGENT), nwg = MT * NT; const long L = (long)i * G + c; if (L >= nwg) return false;
        int wgid = (int)L; { const int q = nwg / NXCD, r = nwg % NXCD, xcd = wgid % NXCD, off = wgid / NXCD; wgid = (xcd < r ? xcd * (q + 1) : r * (q + 1) + (xcd - r) * q) + off; }
        u.pm = wgid / NT; u.pn = wgid % NT; const int e = (int)__hip_atomic_load((unsigned*)tile_e + u.pm, __ATOMIC_RELAXED, __HIP_MEMORY_SCOPE_AGENT); u.boff = (size_t)e * e_bytes + (size_t)u.pn * pn_bytes; return true;
    }
};

__device__ __forceinline__ unsigned pk2(float lo, float hi) { f32x2 v = {lo, hi}; h16x2 h = __builtin_convertvector(v, h16x2); return __builtin_bit_cast(unsigned, h); }
__device__ __forceinline__ float sigmoidf_(float x) { return __builtin_amdgcn_rcpf(1.0f + __builtin_amdgcn_exp2f(-x * LOG2E)); }
__device__ __forceinline__ h16x2 as_h2(unsigned u) { return __builtin_bit_cast(h16x2, u); }
__device__ __forceinline__ f32x4 h4_to_f4(u32x2 w) { const h16x2 a = as_h2(w.x), b = as_h2(w.y); return (f32x4){(float)a.x, (float)a.y, (float)b.x, (float)b.y}; }

typedef f32x4 Acc[2][2][4][2];

struct EpiProj {
    static constexpr bool PERM = true; static constexpr int HOOK_T = -1;
    h16* O; const float* bgate;
    __device__ __forceinline__ void mid(Acc&, const Unit&, int, int, int, int) const {}
    __device__ __forceinline__ void operator()(const Acc& acc, const Unit& u, int wr, int wc, int fr, int fq) const {
        const int row0 = u.pm * BM + wr * 64 + fr, col0 = u.pn * BM + wc * 32 + 8 * fq; const bool isg = col0 >= COL_G;
#pragma unroll
        for (int bj = 0; bj < 2; ++bj) {
            f32x4 b0 = {0.f, 0.f, 0.f, 0.f}, b1 = b0;
            if (isg) { b0 = *(const f32x4*)(bgate + col0 - COL_G + bj * HALF); b1 = *(const f32x4*)(bgate + col0 - COL_G + bj * HALF + 4); }
#pragma unroll
            for (int ai = 0; ai < 2; ++ai)
#pragma unroll
                for (int m = 0; m < 4; ++m) {
                    f32x4 v0 = acc[ai][bj][m][0], v1 = acc[ai][bj][m][1];
                    if (isg) { v0 += b0; v1 += b1;
#pragma unroll
                        for (int e = 0; e < 4; ++e) { v0[e] = sigmoidf_(v0[e]); v1[e] = sigmoidf_(v1[e]); } }
                    u32x4 w; w.x = pk2(v0[0], v0[1]); w.y = pk2(v0[2], v0[3]); w.z = pk2(v1[0], v1[1]); w.w = pk2(v1[2], v1[3]);
                    *(u32x4*)(O + (size_t)(row0 + ai * HALF + m * 16) * INC + col0 + bj * HALF) = w; }
        }
    }
};
struct EpiGlu {
    static constexpr bool PERM = true; static constexpr int HOOK_T = -1;
    const h16* YG; h16* ACAT; const float* bglu;
    __device__ __forceinline__ void mid(Acc&, const Unit&, int, int, int, int) const {}
    __device__ __forceinline__ void operator()(const Acc& acc, const Unit& u, int wr, int wc, int fr, int fq) const {
        const int row0 = u.pm * BM + wr * 64 + fr, col0 = u.pn * BM + wc * 32 + 8 * fq;
#pragma unroll
        for (int bj = 0; bj < 2; ++bj) {
            const f32x4 b0 = *(const f32x4*)(bglu + col0 + bj * HALF), b1 = *(const f32x4*)(bglu + col0 + bj * HALF + 4);
#pragma unroll
            for (int ai = 0; ai < 2; ++ai)
#pragma unroll
                for (int m = 0; m < 4; ++m) {
                    const size_t r = (size_t)(row0 + ai * HALF + m * 16);
                    const u32x4 yw = *(const u32x4*)(YG + r * SSMW + col0 + bj * HALF);
                    const f32x4 y0 = h4_to_f4((u32x2){yw.x, yw.y}), y1 = h4_to_f4((u32x2){yw.z, yw.w});
                    f32x4 v0 = acc[ai][bj][m][0] + b0, v1 = acc[ai][bj][m][1] + b1;
#pragma unroll
                    for (int e = 0; e < 4; ++e) { v0[e] = y0[e] * sigmoidf_(v0[e]); v1[e] = y1[e] * sigmoidf_(v1[e]); }
                    u32x4 w; w.x = pk2(v0[0], v0[1]); w.y = pk2(v0[2], v0[3]); w.z = pk2(v1[0], v1[1]); w.w = pk2(v1[2], v1[3]);
                    if (DBG & 2) w = (u32x4){0u, 0u, 0u, 0u};
                    *(u32x4*)(ACAT + r * 1536 + 512 + col0 + bj * HALF) = w; }
        }
    }
};
struct EpiUp {
    static constexpr bool PERM = true; static constexpr int HOOK_T = 8;
    const h16* PROJ; h16* O;
    __device__ __forceinline__ void mid(Acc& acc, const Unit& u, int wr, int wc, int fr, int fq) const {
        int row0 = u.pm * BM + wr * 64 + fr, col0 = u.pn * BM + wc * 32 + 8 * fq;
        asm volatile("" : "+v"(row0), "+v"(col0));
#pragma unroll
        for (int ai = 0; ai < 2; ++ai)
#pragma unroll
            for (int m = 0; m < 4; ++m)
#pragma unroll
                for (int bj = 0; bj < 2; ++bj) {
                    const h16* gp = PROJ + (size_t)(row0 + ai * HALF + m * 16) * INC + COL_G + col0 + bj * HALF;
                    const u32x4 ga = *(const u32x4*)gp, gs = *(const u32x4*)(gp + D);
                    const f32x4 a0 = h4_to_f4((u32x2){ga.x, ga.y}), a1 = h4_to_f4((u32x2){ga.z, ga.w}), s0 = h4_to_f4((u32x2){gs.x, gs.y}), s1 = h4_to_f4((u32x2){gs.z, gs.w});
#pragma unroll
                    for (int e = 0; e < 4; ++e) { acc[ai][bj][m][0][e] *= a0[e] * __builtin_amdgcn_rcpf(s0[e]); acc[ai][bj][m][1][e] *= a1[e] * __builtin_amdgcn_rcpf(s1[e]); }
                    asm volatile("" : "+v"(acc[ai][bj][m][0]), "+v"(acc[ai][bj][m][1]) :: "memory");
                }
    }
    __device__ __forceinline__ void operator()(const Acc& acc, const Unit& u, int wr, int wc, int fr, int fq) const {
        const int row0 = u.pm * BM + wr * 64 + fr, col0 = u.pn * BM + wc * 32 + 8 * fq;
#pragma unroll
        for (int ai = 0; ai < 2; ++ai)
#pragma unroll
            for (int m = 0; m < 4; ++m)
#pragma unroll
                for (int bj = 0; bj < 2; ++bj) {
                    const size_t r = (size_t)(row0 + ai * HALF + m * 16);
                    const u32x4 gs = *(const u32x4*)(PROJ + r * INC + COL_G + D + col0 + bj * HALF);
                    const f32x4 s0 = h4_to_f4((u32x2){gs.x, gs.y}), s1 = h4_to_f4((u32x2){gs.z, gs.w});
                    const f32x4 v0 = acc[ai][bj][m][0] * s0, v1 = acc[ai][bj][m][1] * s1;
                    u32x4 w; w.x = pk2(v0[0], v0[1]); w.y = pk2(v0[2], v0[3]); w.z = pk2(v1[0], v1[1]); w.w = pk2(v1[2], v1[3]);
                    *(u32x4*)(O + r * D + col0 + bj * HALF) = w; asm volatile("" ::: "memory"); }
    }
};
struct EpiOut {
    static constexpr bool PERM = false; static constexpr int HOOK_T = -1;
    const float* X; float* X1;
    __device__ __forceinline__ void mid(Acc&, const Unit&, int, int, int, int) const {}
    __device__ __forceinline__ void operator()(const Acc& acc, const Unit& u, int wr, int wc, int fr, int fq) const {
        const int row0 = u.pm * BM + wr * 64 + fr, col0 = u.pn * BM + wc * 32 + 4 * fq;
#pragma unroll
        for (int ai = 0; ai < 2; ++ai)
#pragma unroll
            for (int m = 0; m < 4; ++m) { const size_t off = (size_t)(row0 + ai * HALF + m * 16) * D + col0;
#pragma unroll
                for (int bj = 0; bj < 2; ++bj)
#pragma unroll
                    for (int n = 0; n < 2; ++n) *(f32x4*)(X1 + off + bj * HALF + n * 16) = *(const f32x4*)(X + off + bj * HALF + n * 16) + acc[ai][bj][m][n]; }
    }
};
struct EpiGateUp {
    static constexpr bool PERM = true; static constexpr int HOOK_T = -1;
    h16* HID;
    __device__ __forceinline__ void mid(Acc&, const Unit&, int, int, int, int) const {}
    __device__ __forceinline__ void operator()(const Acc& acc, const Unit& u, int wr, int wc, int fr, int fq) const {
        const int row0 = u.pm * BM + wr * 64 + fr, col0 = u.pn * HALF + wc * 32 + 8 * fq;
#pragma unroll
        for (int ai = 0; ai < 2; ++ai)
#pragma unroll
            for (int m = 0; m < 4; ++m) {
                f32x4 v[2];
#pragma unroll
                for (int n = 0; n < 2; ++n)
#pragma unroll
                    for (int e = 0; e < 4; ++e) { const float g = acc[ai][0][m][n][e]; v[n][e] = g * sigmoidf_(g) * acc[ai][1][m][n][e]; }
                u32x4 w; w.x = pk2(v[0][0], v[0][1]); w.y = pk2(v[0][2], v[0][3]); w.z = pk2(v[1][0], v[1][1]); w.w = pk2(v[1][2], v[1][3]);
                *(u32x4*)(HID + (size_t)(row0 + ai * HALF + m * 16) * FF + col0) = w; }
    }
};
struct EpiDown {
    static constexpr bool PERM = true; static constexpr int HOOK_T = -1;
    h16* Y;
    __device__ __forceinline__ void mid(Acc&, const Unit&, int, int, int, int) const {}
    __device__ __forceinline__ void operator()(const Acc& acc, const Unit& u, int wr, int wc, int fr, int fq) const {
        const int row0 = u.pm * BM + wr * 64 + fr, col0 = u.pn * BM + wc * 32 + 8 * fq;
#pragma unroll
        for (int ai = 0; ai < 2; ++ai)
#pragma unroll
            for (int m = 0; m < 4; ++m)
#pragma unroll
                for (int bj = 0; bj < 2; ++bj) {
                    const f32x4 v0 = acc[ai][bj][m][0], v1 = acc[ai][bj][m][1];
                    u32x4 w; w.x = pk2(v0[0], v0[1]); w.y = pk2(v0[2], v0[3]); w.z = pk2(v1[0], v1[1]); w.w = pk2(v1[2], v1[3]);
                    *(u32x4*)(Y + (size_t)(row0 + ai * HALF + m * 16) * D + col0 + bj * HALF) = w; }
    }
};

template <class Epi, class Sched, bool ALIGN_EPI = true>
__device__ __forceinline__ void gemm_phase(LAS unsigned char* lds, const Gemm g, const Sched& S, const Epi& E) {
    const int tid = threadIdx.x, wid = __builtin_amdgcn_readfirstlane(tid >> 6), lane = tid & 63, wr = wid >> 2, wc = wid & 3, fr = lane & 15, fq = lane >> 4;
    const int K = g.K, nt = K / BK;
    unsigned voffA[2], voffB[2];
#pragma unroll
    for (int i = 0; i < 2; ++i) { int R, C; stage_rc(tid * 16 + i * 8192, R, C); const int Rb = Epi::PERM ? ((R & ~31) + perm32(R & 31)) : R;
        voffA[i] = (unsigned)(R * K + C) * 2u; voffB[i] = (unsigned)(Rb * K + C) * 2u; }
    const size_t kstep = (size_t)(BK * 2);
    const size_t hstepA = (size_t)HALF * K * 2, hstepB = g.b_hstep;
    const size_t tstepA = 2 * hstepA;
    const unsigned ldsw = (unsigned)wid * 1024u;
    const int aoff = lds_byte(wr * 64 + fr, fq * 8), boff = lds_byte(wc * 32 + fr, fq * 8);
#define PG8_SA(b, h) (((b) * 2 + (h)) * HTB)
#define PG8_SB(b, h) ((4 + (b) * 2 + (h)) * HTB)
#define PG8_STAGE(bufoff, gbase, voff) do { _Pragma("unroll") for (int _i = 0; _i < 2; ++_i) \
        __builtin_amdgcn_global_load_lds((const unsigned*)((const char*)(gbase) + (voff)[_i]), (LAS unsigned*)(lds + (bufoff) + ldsw + _i * 8192), 16, 0, 0); } while (0)
#define PG8_LDA(dst, b, h) do { _Pragma("unroll") for (int m = 0; m < 4; ++m) _Pragma("unroll") for (int k = 0; k < 2; ++k) dst[m][k] = *(const LAS h16x8*)(lds + PG8_SA(b, h) + aoff + m * 2048 + k * 1024); } while (0)
#define PG8_LDB(dst, b, h) do { _Pragma("unroll") for (int n = 0; n < 2; ++n) _Pragma("unroll") for (int k = 0; k < 2; ++k) dst[n][k] = *(const LAS h16x8*)(lds + PG8_SB(b, h) + boff + n * 2048 + k * 1024); } while (0)
#define PG8_MMA(ai, bj, At, Bt) do { __builtin_amdgcn_s_setprio(1); _Pragma("unroll") for (int m = 0; m < 4; ++m) _Pragma("unroll") for (int n = 0; n < 2; ++n) _Pragma("unroll") for (int k = 0; k < 2; ++k) \
        acc[ai][bj][m][n] = __builtin_amdgcn_mfma_f32_16x16x32_f16(Bt[n][k], At[m][k], acc[ai][bj][m][n], 0, 0, 0); __builtin_amdgcn_s_setprio(0); } while (0)
#define PG8_WAIT_V(n) asm volatile("s_waitcnt vmcnt(" #n ")" ::: "memory")
#define PG8_WAIT_L(n) asm volatile("s_waitcnt lgkmcnt(" #n ")" ::: "memory")
#define PG8_BAR __builtin_amdgcn_s_barrier()
#define PG8_SCHED __builtin_amdgcn_sched_barrier(0)
    Unit cur, nxt; int ui = 0;
    if (!S.next(0, cur)) return;
    Acc acc;
#pragma unroll
    for (int a = 0; a < 2; ++a)
#pragma unroll
        for (int b = 0; b < 2; ++b)
#pragma unroll
            for (int m = 0; m < 4; ++m)
#pragma unroll
                for (int n = 0; n < 2; ++n) acc[a][b][m][n] = (f32x4){0.f, 0.f, 0.f, 0.f};
    h16x8 At[4][2], B0[2][2], B1[2][2];
    const char* cA = (const char*)g.A + (size_t)cur.pm * tstepA; const char* cB = (const char*)g.Bt + cur.boff;
    PG8_STAGE(PG8_SB(0, 0), cB, voffB); PG8_STAGE(PG8_SB(0, 1), cB + hstepB, voffB); PG8_STAGE(PG8_SA(0, 0), cA, voffA); PG8_STAGE(PG8_SA(0, 1), cA + hstepA, voffA);
    if (wr == 1) PG8_BAR;
    PG8_WAIT_V(2); PG8_BAR;
    PG8_STAGE(PG8_SB(1, 0), cB + kstep, voffB); PG8_STAGE(PG8_SA(1, 0), cA + kstep, voffA); PG8_STAGE(PG8_SB(1, 1), cB + hstepB + kstep, voffB);
    PG8_WAIT_V(6); PG8_BAR;
    for (;;) {
        const bool has_next = S.next(ui + 1, nxt);
        const char* nA = has_next ? (const char*)g.A + (size_t)nxt.pm * tstepA : cA; const char* nB = has_next ? (const char*)g.Bt + nxt.boff : cB;
        for (int t = 0; t < nt; t += 2) {
            if (Epi::HOOK_T >= 0 && t == Epi::HOOK_T) E.mid(acc, cur, wr, wc, fr, fq);
            const bool last = (t == nt - 2);
            const char* a1 = cA + (size_t)(t + 1) * kstep;
            const char* a2 = last ? nA : cA + (size_t)(t + 2) * kstep; const char* b2 = last ? nB : cB + (size_t)(t + 2) * kstep;
            const char* a3 = a2 + kstep; const char* b3 = b2 + kstep;
            PG8_LDB(B0, 0, 0); PG8_LDB(B1, 0, 1); PG8_SCHED; PG8_LDA(At, 0, 0); PG8_STAGE(PG8_SA(1, 1), a1 + hstepA, voffA);
            PG8_WAIT_V(8); PG8_WAIT_L(0); PG8_BAR; PG8_MMA(0, 0, At, B0); PG8_MMA(0, 1, At, B1); PG8_BAR; PG8_SCHED;
            PG8_LDA(At, 0, 1); PG8_STAGE(PG8_SB(0, 0), b2, voffB); PG8_STAGE(PG8_SB(0, 1), b2 + hstepB, voffB); PG8_STAGE(PG8_SA(0, 0), a2, voffA);
            PG8_WAIT_V(8); PG8_WAIT_L(0); PG8_BAR; PG8_MMA(1, 0, At, B0); PG8_MMA(1, 1, At, B1); PG8_BAR; PG8_SCHED;
            PG8_LDB(B0, 1, 0); PG8_LDB(B1, 1, 1); PG8_SCHED; PG8_LDA(At, 1, 0); PG8_STAGE(PG8_SA(0, 1), a2 + hstepA, voffA);
            PG8_WAIT_V(8); PG8_WAIT_L(0); PG8_BAR; PG8_MMA(0, 0, At, B0); PG8_MMA(0, 1, At, B1); PG8_BAR; PG8_SCHED;
            PG8_LDA(At, 1, 1); PG8_STAGE(PG8_SB(1, 0), b3, voffB); PG8_STAGE(PG8_SB(1, 1), b3 + hstepB, voffB); PG8_STAGE(PG8_SA(1, 0), a3, voffA);
            PG8_WAIT_V(8); PG8_WAIT_L(0); PG8_BAR; PG8_MMA(1, 0, At, B0); PG8_MMA(1, 1, At, B1); PG8_BAR; PG8_SCHED;
        }
        if constexpr (ALIGN_EPI) { if (wr == 0) PG8_BAR; }
        E(acc, cur, wr, wc, fr, fq);
        if (!has_next) break;
#pragma unroll
        for (int a = 0; a < 2; ++a)
#pragma unroll
            for (int b = 0; b < 2; ++b)
#pragma unroll
                for (int m = 0; m < 4; ++m)
#pragma unroll
                    for (int n = 0; n < 2; ++n) acc[a][b][m][n] = (f32x4){0.f, 0.f, 0.f, 0.f};
        cur = nxt; cA = nA; cB = nB; ++ui;
        if constexpr (ALIGN_EPI) { if (wr == 1) PG8_BAR; }
    }
    PG8_WAIT_V(0);
    if constexpr (!ALIGN_EPI) { if (wr == 0) PG8_BAR; }
    PG8_BAR;
#undef PG8_SA
#undef PG8_SB
#undef PG8_STAGE
#undef PG8_LDA
#undef PG8_LDB
#undef PG8_MMA
#undef PG8_WAIT_V
#undef PG8_WAIT_L
#undef PG8_BAR
#undef PG8_SCHED
}
}
using pg8::pk2;

constexpr int NWAVES = 8;
constexpr int RING_BYTES = 131072;
constexpr int LDSCTL_OFF = RING_BYTES, MISC_OFF = LDSCTL_OFF + 320;
constexpr int LDS_BYTES = 147456;

typedef GAS unsigned gu32;
#define RLX_AGENT __ATOMIC_RELAXED, __HIP_MEMORY_SCOPE_AGENT
#define XB_TMO      128
#define XB_XCNT(j)  (256  + 64 * (j))
#define XB_XSUB(j)  (1280 + 64 * (j))
#define XB_XGEN(j)  (2304 + 64 * (j))
#define XB_TOP      3328
#define XB_TOPGEN   3392
#define XCD_BAR_WORDS 3456
#define XB_SPIN_CAP (1u << 18)
__device__ __forceinline__ unsigned xb_ld(unsigned* p)              { return __hip_atomic_load(p, __ATOMIC_RELAXED, __HIP_MEMORY_SCOPE_AGENT); }
__device__ __forceinline__ unsigned xb_add(unsigned* p, unsigned v) { return __hip_atomic_fetch_add(p, v, __ATOMIC_RELAXED, __HIP_MEMORY_SCOPE_AGENT); }
__device__ __forceinline__ unsigned xb_xcc_id() { return (unsigned)__builtin_amdgcn_s_getreg((3 << 11) | 20) & 0xFu; }
#define XB_SPIN(cond, bar) do { unsigned _sp = 0; while (cond) { __builtin_amdgcn_s_sleep(1); \
    if ((++_sp & 255u) == 0u) { if (xb_ld(&(bar)[XB_TMO])) break; if (_sp > XB_SPIN_CAP) { atomicAdd(&(bar)[XB_TMO], 1u); break; } } } } while (0)
struct XcdBarrier { unsigned* bar; unsigned x; volatile LAS unsigned* st; };
__device__ __forceinline__ XcdBarrier xcd_barrier_post(unsigned* bar, volatile LAS unsigned* st) {
    XcdBarrier b; b.bar = bar; b.x = xb_xcc_id(); b.st = st;
    if (threadIdx.x == 0) (void)xb_add(&bar[XB_XCNT(b.x)], 1u);
    return b;
}
__device__ __forceinline__ void xcd_barrier_complete(unsigned* bar, unsigned x, unsigned& nloc, unsigned& nx) {
    const unsigned G = gridDim.x * gridDim.y * gridDim.z;
    unsigned sum, cnt, mine, sp = 0u;
    for (;;) {
        sum = 0u; cnt = 0u; mine = 0u;
#pragma unroll
        for (unsigned j = 0; j < 16; ++j) { const unsigned c = xb_ld(&bar[XB_XCNT(j)]); sum += c; cnt += (c > 0u) ? 1u : 0u; mine = (j == x) ? c : mine; }
        if (sum == G) break;
        __builtin_amdgcn_s_sleep(1);
        if ((++sp & 255u) == 0u) { if (xb_ld(&bar[XB_TMO])) break; if (sp > XB_SPIN_CAP) { atomicAdd(&bar[XB_TMO], 1u); break; } }
    }
    nloc = mine > 0u ? mine : 1u; nx = cnt > 0u ? cnt : 1u;
}
__device__ __forceinline__ void xcd_barrier(const XcdBarrier& b) {
    asm volatile("s_waitcnt vmcnt(0)" ::: "memory");
    __syncthreads();
    if (threadIdx.x == 0) {
        unsigned* bar = b.bar;
        __builtin_amdgcn_s_waitcnt(0);
        unsigned nloc = b.st[0], nx = b.st[1];
        if (nloc == 0u) { xcd_barrier_complete(bar, b.x, nloc, nx); b.st[0] = nloc; b.st[1] = nx; }
        const unsigned old = xb_add(&bar[XB_XSUB(b.x)], 1u);
        const unsigned gen = old / nloc;
        if (old + 1u == (gen + 1u) * nloc) {
            __builtin_amdgcn_fence(__ATOMIC_RELEASE, "agent");
            asm volatile("s_waitcnt vmcnt(0)" ::: "memory");
            const unsigned og = xb_add(&bar[XB_TOP], 1u);
            const unsigned tg = og / nx;
            if (og + 1u == (tg + 1u) * nx) xb_add(&bar[XB_TOPGEN], 1u);
            else XB_SPIN(xb_ld(&bar[XB_TOPGEN]) == tg, bar);
            __builtin_amdgcn_fence(__ATOMIC_ACQUIRE, "agent");
            xb_add(&bar[XB_XGEN(b.x)], 1u);
            asm volatile("s_waitcnt vmcnt(0)" ::: "memory");
        } else {
            XB_SPIN(xb_ld(&bar[XB_XGEN(b.x)]) == gen, bar);
            __builtin_amdgcn_fence(__ATOMIC_ACQUIRE, "agent");
            asm volatile("s_waitcnt vmcnt(0)" ::: "memory");
        }
    }
    __syncthreads();
}

struct Args { const float* in[26]; float* out; unsigned char* ws; int ph_lo, ph_hi, chk, pad; };
struct Frame {
    LAS unsigned char* lds; unsigned char* ws; int tid, lane, wave, G, gw, NGW;
};
#define LDS_WAIT() asm volatile("s_waitcnt lgkmcnt(0)" ::: "memory")
__device__ __forceinline__ float wave_sum(float v) {
#pragma unroll
    for (int o = 1; o < 64; o <<= 1) v += __shfl_xor(v, o);
    return v;
}
__device__ __forceinline__ float gelu_tanh(float x) {
    const float z = 0.7978845608028654f * (x + 0.044715f * x * x * x);
    const float e = __builtin_amdgcn_exp2f(2.0f * LOG2E * z);
    const float th = 1.0f - 2.0f * __builtin_amdgcn_rcpf(e + 1.0f);
    return 0.5f * x * (1.0f + th);
}

__device__ __forceinline__ void p0_transpose_item(const float* W, int N, h16* WT, int ldo, int koff, int row_off, LAS float* scr, int item, int lane) {
    const int nblk = N / 32, kb = item / nblk, nb = item % nblk, k0 = 64 * kb, n0 = 32 * nb;
#pragma unroll 8
    for (int i = 0; i < 32; ++i) { const int kk = 2 * i + (lane >> 5); scr[kk * 33 + (lane & 31)] = W[(size_t)(k0 + kk) * N + n0 + (lane & 31)]; }
    LDS_WAIT(); asm volatile("" ::: "memory");
    const int c = lane & 7;
#pragma unroll
    for (int j = 0; j < 4; ++j) { const int n = (lane >> 3) + 8 * j; const LAS float* s = scr + (8 * c) * 33 + n;
        u32x4 o; o.x = pk2(s[0 * 33], s[1 * 33]); o.y = pk2(s[2 * 33], s[3 * 33]); o.z = pk2(s[4 * 33], s[5 * 33]); o.w = pk2(s[6 * 33], s[7 * 33]);
        *(u32x4*)(WT + (size_t)(row_off + n0 + n) * ldo + koff + k0 + 8 * c) = o; }
    LDS_WAIT(); asm volatile("" ::: "memory");
}
__device__ __forceinline__ void rms_row_to_h16(const float* xrow, const float* gain, h16* orow, int lane) {
    const f32x4* xr = (const f32x4*)xrow + lane; const f32x4* gr = (const f32x4*)gain + lane;
    f32x4 v[8]; float s = 0.f;
#pragma unroll
    for (int j = 0; j < 8; ++j) { v[j] = xr[64 * j]; s += (v[j].x * v[j].x + v[j].y * v[j].y) + (v[j].z * v[j].z + v[j].w * v[j].w); }
    const float r = 1.0f / sqrtf(wave_sum(s) * (1.0f / D) + EPS);
    u32x2* o8 = (u32x2*)orow + lane;
#pragma unroll
    for (int j = 0; j < 8; ++j) { const f32x4 g = gr[64 * j]; u32x2 w; w.x = pk2(v[j].x * r * g.x, v[j].y * r * g.y); w.y = pk2(v[j].z * r * g.z, v[j].w * r * g.w); o8[64 * j] = w; }
}

template <bool FULL>
__device__ __forceinline__ void ssm_item(const Frame& F, const float* const* in, int g, int c, LAS unsigned char* wl) {
    unsigned char* ws = F.ws; const int lane = F.lane, lq = lane >> 4, lr = lane & 15;
    const f32x4 ab = ((const f32x4*)(ws + WS_AB))[g * 64 + lane];
    const float ar = ab.x, ai = ab.y;
    const h16* PROJ = (const h16*)(ws + WS_PROJ);
    h16x8 bfrag[8];
    const h16x8 zero8 = {0, 0, 0, 0, 0, 0, 0, 0};
#pragma unroll
    for (int mt = 0; mt < 8; ++mt) bfrag[mt] = lq < 2 ? *(const h16x8*)((const h16*)(ws + WS_BB) + ((size_t)(g * 128 + 16 * mt + lr)) * 16 + 8 * lq) : zero8;
    h16x8 cfrag[4];
    if (FULL) {
#pragma unroll
        for (int s = 0; s < 4; ++s) cfrag[s] = *(const h16x8*)((const h16*)(ws + WS_CT) + ((size_t)(g * 16 + lr)) * 128 + 32 * s + 8 * lq);
    }
    float xr = 0.f, xi = 0.f;
    const f32x2* Sg = (const f32x2*)(ws + WS_S) + (size_t)g * 64 + lane;
    if (FULL) {
        const float alr = ab.z, ali = ab.w;
        for (int cc = 0; cc < c; ++cc) { const f32x2 s = Sg[(size_t)cc * 4096]; const float nr = alr * xr - ali * xi + s.x, ni = alr * xi + ali * xr + s.y; xr = nr; xi = ni; }
    }
    const int t0 = 64 * c;
    for (int sub = 0; sub < 4; ++sub) {
        const int ts = t0 + 16 * sub;
        const h16x8 ufrag = lq < 2 ? *(const h16x8*)(PROJ + (size_t)(ts + lr) * INC + COL_U + 16 * g + 8 * lq) : zero8;
#pragma unroll
        for (int mt = 0; mt < 8; ++mt) {
            f32x4 a = {0.f, 0.f, 0.f, 0.f};
            a = __builtin_amdgcn_mfma_f32_16x16x32_f16(bfrag[mt], ufrag, a, 0, 0, 0);
            *(LAS f32x4*)(wl + lr * 528 + (16 * mt + 4 * lq) * 4) = a;
        }
        f32x2 bu[16];
#pragma unroll
        for (int t = 0; t < 16; ++t) bu[t] = *(const LAS f32x2*)(wl + t * 528 + 8 * lane);
#pragma unroll
        for (int t = 0; t < 16; ++t) {
            const float nr = ar * xr - ai * xi + bu[t].x, ni = ar * xi + ai * xr + bu[t].y; xr = nr; xi = ni;
            if (FULL) *(LAS unsigned*)(wl + t * 528 + 4 * lane) = pk2(xr, xi);
        }
        if (FULL) {
            f32x4 y = {0.f, 0.f, 0.f, 0.f};
#pragma unroll
            for (int s = 0; s < 4; ++s) { const h16x8 xf = *(const LAS h16x8*)(wl + lr * 528 + (32 * s + 8 * lq) * 2); y = __builtin_amdgcn_mfma_f32_16x16x32_f16(cfrag[s], xf, y, 0, 0, 0); }
            const u32x2 uw = *(const u32x2*)(PROJ + (size_t)(ts + lr) * INC + COL_U + 16 * g + 4 * lq);
            const f32x4 u4 = pg8::h4_to_f4(uw), d4 = *(const f32x4*)(in[11] + 16 * g + 4 * lq);
            f32x4 o;
#pragma unroll
            for (int e = 0; e < 4; ++e) o[e] = gelu_tanh(y[e] + d4[e] * u4[e]);
            u32x2 w; w.x = pk2(o[0], o[1]); w.y = pk2(o[2], o[3]);
            *(u32x2*)((h16*)(ws + WS_YG) + (size_t)(ts + lr) * SSMW + 16 * g + 4 * lq) = w;
        }
    }
    if (!FULL) ((f32x2*)(ws + WS_S))[(size_t)c * 4096 + g * 64 + lane] = (f32x2){xr, xi};
}

__device__ __forceinline__ s16x4 tr_read(const LAS unsigned char* p) {
    typedef short v4i16_t __attribute__((ext_vector_type(4)));
    return __builtin_amdgcn_ds_read_tr16_b64_v4i16((LAS v4i16_t*)p);
}
__device__ __forceinline__ void attn_pair(const Frame& F, int item0) {
    unsigned char* ws = F.ws; const int tid = F.tid, lane = F.lane, wave = F.wave;
    const int half = wave >> 2, qt = wave & 3, r = lane & 31, hh = lane >> 5;
    const int item = item0 + half;
    const int g = item >> 9, hs = (item >> 6) & 7, blk = item & 63;
    const int dl = (g == 0) ? 0 : (g == 1 ? 2 : 4), dil = 1 << dl, res = blk & (dil - 1), n = blk >> dl;
    const h16* PROJ = (const h16*)(ws + WS_PROJ);
    const int hcol = (g * 8 + hs) * 64;
    LAS unsigned char* vimg = F.lds + half * 32768;
    {
        const int t2 = tid & 255, c8 = t2 & 7;
#pragma unroll
        for (int j = 0; j < 8; ++j) {
            const int kj = (t2 >> 3) + 32 * j, idx = (n - 1) * 128 + kj;
            u32x4 v = {0u, 0u, 0u, 0u};
            if (idx >= 0) v = *(const u32x4*)(PROJ + (size_t)(idx * dil + res) * INC + COL_V + hcol + 8 * c8);
            *(LAS u32x4*)(vimg + kj * 128 + c8 * 16) = v;
        }
    }
    const int qpos = ((n * 128 + 32 * qt + r) << dl) + res;
    h16x8 qf[4];
#pragma unroll
    for (int s = 0; s < 4; ++s) qf[s] = *(const h16x8*)(PROJ + (size_t)qpos * INC + hcol + 16 * s + 8 * hh);
    __builtin_amdgcn_sched_barrier(0);
    const float c1 = 0.125f * LOG2E, c2 = __builtin_amdgcn_exp2f(-(float)(hs + 1)) * (float)dil * LOG2E;
    float mx = -INFINITY;
    f32x16 sc[5];
#pragma unroll
    for (int k5 = 0; k5 < 5; ++k5) {
        const int kj = 32 * (qt + k5) + r, idx = (n - 1) * 128 + kj, pos = ((idx < 0 ? 0 : idx) << dl) + res;
        h16x8 kf[4];
#pragma unroll
        for (int s = 0; s < 4; ++s) kf[s] = *(const h16x8*)(PROJ + (size_t)pos * INC + COL_K + hcol + 16 * s + 8 * hh);
        f32x16 a = {0.f, 0.f, 0.f, 0.f, 0.f, 0.f, 0.f, 0.f, 0.f, 0.f, 0.f, 0.f, 0.f, 0.f, 0.f, 0.f};
#pragma unroll
        for (int s = 0; s < 4; ++s) a = __builtin_amdgcn_mfma_f32_32x32x16_f16(kf[s], qf[s], a, 0, 0, 0);
        const int sbase = 128 + r - 32 * k5 - 4 * hh;
        const bool tile_ok = (n > 0) || (qt + k5 >= 4);
        const float fb = -c2 * (float)sbase;
#pragma unroll
        for (int i = 0; i < 16; ++i) {
            const int ci = (i & 3) + 8 * (i >> 2);
            const bool ok = tile_ok && ((unsigned)(sbase - ci) <= 128u);
            const float v = ok ? __builtin_fmaf(a[i], c1, fb + c2 * (float)ci) : -INFINITY;
            a[i] = v; mx = fmaxf(mx, v);
        }
        sc[k5] = a;
        __builtin_amdgcn_sched_barrier(0);
    }
    mx = fmaxf(mx, __shfl_xor(mx, 32));
    float l = 0.f;
#pragma unroll
    for (int k5 = 0; k5 < 5; ++k5)
#pragma unroll
        for (int i = 0; i < 16; ++i) { const float p = __builtin_amdgcn_exp2f(sc[k5][i] - mx); sc[k5][i] = p; l += p; }
    l += __shfl_xor(l, 32);
    __syncthreads();
    f32x16 o0 = {0.f, 0.f, 0.f, 0.f, 0.f, 0.f, 0.f, 0.f, 0.f, 0.f, 0.f, 0.f, 0.f, 0.f, 0.f, 0.f}, o1 = o0;
    const int vq = (lane & 15) >> 2, vp = lane & 3, vg = (lane >> 4) & 1;
    const LAS unsigned char* vb = vimg + (4 * hh + vq) * 128 + (16 * vg + 4 * vp) * 2;
#pragma unroll
    for (int k5 = 0; k5 < 5; ++k5)
#pragma unroll
        for (int s = 0; s < 2; ++s) {
            u32x4 pw; pw.x = pk2(sc[k5][8 * s + 0], sc[k5][8 * s + 1]); pw.y = pk2(sc[k5][8 * s + 2], sc[k5][8 * s + 3]); pw.z = pk2(sc[k5][8 * s + 4], sc[k5][8 * s + 5]); pw.w = pk2(sc[k5][8 * s + 6], sc[k5][8 * s + 7]);
            const h16x8 pf = __builtin_bit_cast(h16x8, pw);
            const LAS unsigned char* vr = vb + (32 * (qt + k5) + 16 * s) * 128;
            const s16x4 a0 = tr_read(vr), a1 = tr_read(vr + 8 * 128), b0 = tr_read(vr + 64), b1 = tr_read(vr + 8 * 128 + 64);
            typedef short s16x8 __attribute__((ext_vector_type(8)));
            const s16x8 va = {a0[0], a0[1], a0[2], a0[3], a1[0], a1[1], a1[2], a1[3]}, vbb = {b0[0], b0[1], b0[2], b0[3], b1[0], b1[1], b1[2], b1[3]};
            o0 = __builtin_amdgcn_mfma_f32_32x32x16_f16(__builtin_bit_cast(h16x8, va), pf, o0, 0, 0, 0);
            o1 = __builtin_amdgcn_mfma_f32_32x32x16_f16(__builtin_bit_cast(h16x8, vbb), pf, o1, 0, 0, 0);
        }
    const float il = 1.0f / l;
    h16* og = (h16*)(ws + WS_OG) + ((size_t)g * T + qpos) * 512 + hs * 64;
#pragma unroll
    for (int q4 = 0; q4 < 4; ++q4) {
        u32x2 w; w.x = pk2(o0[4 * q4] * il, o0[4 * q4 + 1] * il); w.y = pk2(o0[4 * q4 + 2] * il, o0[4 * q4 + 3] * il);
        *(u32x2*)(og + 8 * q4 + 4 * hh) = w;
        w.x = pk2(o1[4 * q4] * il, o1[4 * q4 + 1] * il); w.y = pk2(o1[4 * q4 + 2] * il, o1[4 * q4 + 3] * il);
        *(u32x2*)(og + 32 + 8 * q4 + 4 * hh) = w;
    }
    if (hh == 0) ((float*)(ws + WS_LSE))[((size_t)g * T + qpos) * 8 + hs] = mx * LN2 + __logf(l);
    __syncthreads();
}


#ifndef DBGCHK
#define DBGCHK 0
#endif
constexpr int CW_DBG = 8256;
__device__ __forceinline__ unsigned hsh(unsigned x) { x ^= x >> 16; x *= 0x7feb352du; x ^= x >> 15; x *= 0x846ca68bu; x ^= x >> 16; return x; }
__device__ __forceinline__ void chk_fail(unsigned* ctl, int code) { atomicMax(ctl + CW_DBG, (unsigned)(100 - code)); }
__device__ __forceinline__ bool close_(float a, float b) { return fabsf(a - b) <= 0.01f * fabsf(b) + 0.01f && a == a; }
__device__ __forceinline__ float dot_hh(const h16* a, const h16* b, int K) { float s = 0.f; for (int k = 0; k < K; ++k) s += (float)a[k] * (float)b[k]; return s; }
__device__ __forceinline__ void run_checks(int after, const float* const* in, unsigned char* ws, unsigned* ctl, int tid) {
    const unsigned r0 = hsh(tid * 7919u + after * 104729u + 12345u), r1 = hsh(r0 + 1u), r2 = hsh(r1 + 7u);
    const h16* PROJ = (const h16*)(ws + WS_PROJ);
    if (after == 0) {
        {
            const int row = r0 % T, col = r1 % D; const float* xr = in[0] + (size_t)row * D; float ss = 0.f;
            for (int k = 0; k < D; ++k) ss += xr[k] * xr[k];
            const float v = xr[col] / sqrtf(ss / D + EPS) * in[1][col];
            if (!close_((float)((const h16*)(ws + WS_H))[(size_t)row * D + col], v)) chk_fail(ctl, 1);
        }
        {
            int n = r1 % INC, k = r2 % D;
            if (!close_((float)((const h16*)(ws + WS_WIN))[(size_t)n * D + k], in[2][(size_t)k * INC + n])) chk_fail(ctl, 2);
            n = r1 % 1024; k = r2 % 1024;
            if (!close_((float)((const h16*)(ws + WS_WGLU))[(size_t)n * 1024 + k], in[12][(size_t)k * 1024 + n])) chk_fail(ctl, 2);
            n = r1 % D; k = r2 % 512;
            if (!close_((float)((const h16*)(ws + WS_WUP))[(size_t)n * 1536 + k], in[14][(size_t)k * D + n])) chk_fail(ctl, 2);
            k = r2 % 1024;
            if (!close_((float)((const h16*)(ws + WS_WUP))[(size_t)n * 1536 + 512 + k], in[15][(size_t)k * D + n])) chk_fail(ctl, 2);
            k = r2 % D;
            if (!close_((float)((const h16*)(ws + WS_WOUT))[(size_t)n * D + k], in[16][(size_t)k * D + n])) chk_fail(ctl, 2);
            const int e = r0 % NE; n = r1 % FF; k = r2 % D;
            if (!close_((float)((const h16*)(ws + WS_WGU))[((size_t)e * 1024 + n) * D + k], in[22][((size_t)e * D + k) * FF + n])) chk_fail(ctl, 2);
            if (!close_((float)((const h16*)(ws + WS_WGU))[((size_t)e * 1024 + 512 + n) * D + k], in[23][((size_t)e * D + k) * FF + n])) chk_fail(ctl, 2);
            n = r1 % D; k = r2 % FF;
            if (!close_((float)((const h16*)(ws + WS_WDN))[((size_t)e * D + n) * FF + k], in[24][((size_t)e * FF + k) * D + n])) chk_fail(ctl, 2);
        }
    }
    if (after == 1) {
        const int row = r0 % T; int col = r1 % INC; if (tid & 1) col = COL_G + (r1 % 4096);
        float v = dot_hh((const h16*)(ws + WS_H) + (size_t)row * D, (const h16*)(ws + WS_WIN) + (size_t)col * D, D);
        if (col >= COL_G) v = 1.f / (1.f + expf(-(v + in[3][col - COL_G])));
        if (!close_((float)PROJ[(size_t)row * INC + col], v)) chk_fail(ctl, 3);
    }
    if (after == 2) {
        const int g = r0 % 3, t = r1 % T, hs = r2 % 8, dil = (g == 0) ? 1 : (g == 1 ? 4 : 16), hcol = (g * 8 + hs) * 64;
        const float slope = exp2f(-(float)(hs + 1));
        const h16* q = PROJ + (size_t)t * INC + hcol;
        float mx = -INFINITY;
        for (int j = 0; j <= 128; ++j) { const int tk = t - j * dil; if (tk < 0) break; const float sc = dot_hh(q, PROJ + (size_t)tk * INC + COL_K + hcol, 64) * 0.125f - slope * (float)(dil * j); mx = fmaxf(mx, sc); }
        float l = 0.f, o0 = 0.f, o1 = 0.f; const int d0 = r2 % 64, d1 = (r2 >> 8) % 64;
        for (int j = 0; j <= 128; ++j) { const int tk = t - j * dil; if (tk < 0) break; const float sc = dot_hh(q, PROJ + (size_t)tk * INC + COL_K + hcol, 64) * 0.125f - slope * (float)(dil * j);
            const float p = expf(sc - mx); l += p; o0 += p * (float)PROJ[(size_t)tk * INC + COL_V + hcol + d0]; o1 += p * (float)PROJ[(size_t)tk * INC + COL_V + hcol + d1]; }
        const h16* og = (const h16*)(ws + WS_OG) + ((size_t)g * T + t) * 512 + hs * 64;
        if (!close_((float)og[d0], o0 / l) || !close_((float)og[d1], o1 / l)) chk_fail(ctl, 4);
        if (!close_(((const float*)(ws + WS_LSE))[((size_t)g * T + t) * 8 + hs], mx + logf(l))) chk_fail(ctl, 5);
    }
    if (after == 3) {
        {
            const int t = r0 % T, hs = r1 % 8, d = r2 % 64; const float* LSE = (const float*)(ws + WS_LSE);
            float lse[3], m = -INFINITY; for (int g = 0; g < 3; ++g) { lse[g] = LSE[((size_t)g * T + t) * 8 + hs]; m = fmaxf(m, lse[g]); }
            float den = 0.f, num = 0.f; for (int g = 0; g < 3; ++g) { const float w = expf(lse[g] - m); den += w; num += w * (float)((const h16*)(ws + WS_OG))[((size_t)g * T + t) * 512 + hs * 64 + d]; }
            const h16 av = ((const h16*)(ws + WS_ACAT))[(size_t)t * 1536 + hs * 64 + d]; const float bv = num / den;
            if (__builtin_bit_cast(unsigned short, av) == 0xAAAAu) chk_fail(ctl, 6);
            else if (!(fabsf(bv) < 1e30f)) chk_fail(ctl, 7);
            else if (!close_((float)av, bv)) { chk_fail(ctl, 8); atomicAdd(ctl + CW_DBG + 1, 1u); if (t < 2048) atomicAdd(ctl + CW_DBG + 2, 1u); }
        }
        {
            const int wv = tid >> 6, p = tid & 63, gq = (wv * 9 + 3) % 64, gp = gq * 64 + p;
            const float are = in[4][gp], aim = in[5][gp], step = expf(in[6][gq]), mag = expf(are * step), ang = aim * step;
            const float br = mag * cosf(ang), bi = mag * sinf(ang), nr = br - 1.f, ni = bi, den = are * are + aim * aim;
            const float fr_ = (nr * are + ni * aim) / den, fi_ = (ni * are - nr * aim) / den;
            float bbr[16], bbi[16];
#pragma unroll
            for (int h = 0; h < 16; ++h) { const float b_r = in[7][(size_t)gp * 16 + h], b_i = in[8][(size_t)gp * 16 + h]; bbr[h] = fr_ * b_r - fi_ * b_i; bbi[h] = fr_ * b_i + fi_ * b_r; }
            float xr = 0.f, xi = 0.f; int ci = 0, tn = 5;
            for (int t = 0; t < T; ++t) {
                float bur = 0.f, bui = 0.f;
#pragma unroll
                for (int h = 0; h < 16; ++h) { const float u = (float)PROJ[(size_t)t * INC + COL_U + gq * 16 + h]; bur += bbr[h] * u; bui += bbi[h] * u; }
                const float nr2 = br * xr - bi * xi + bur, ni2 = br * xi + bi * xr + bui; xr = nr2; xi = ni2;
                if (t == tn) {
                    for (int h = 0; h < 16; ++h) {
                        float yv = in[9][((size_t)gq * 16 + h) * 64 + p] * xr - in[10][((size_t)gq * 16 + h) * 64 + p] * xi;
                        yv = wave_sum(yv);
                        yv += in[11][gq * 16 + h] * (float)PROJ[(size_t)t * INC + COL_U + gq * 16 + h];
                        const float z = 0.7978845608028654f * (yv + 0.044715f * yv * yv * yv), ge = 0.5f * yv * (1.f + tanhf(z));
                        if (p == 0 && !close_((float)((const h16*)(ws + WS_YG))[(size_t)t * SSMW + gq * 16 + h], ge)) chk_fail(ctl, 9);
                    }
                    ++ci; tn = (ci == 1) ? 64 + wv : (ci == 2 ? 1000 + 17 * wv : T - 1);
                }
            }
        }
    }
    if (after == 4) {
        const int row = r0 % T, c = r1 % 1024; const h16* yg = (const h16*)(ws + WS_YG) + (size_t)row * SSMW;
        const float v = dot_hh(yg, (const h16*)(ws + WS_WGLU) + (size_t)c * 1024, 1024) + in[13][c];
        if (!close_((float)((const h16*)(ws + WS_ACAT))[(size_t)row * 1536 + 512 + c], (float)yg[c] / (1.f + expf(-v)))) chk_fail(ctl, 10);
    }
    if (after == 5) {
        const int row = r0 % T, c = r1 % D; const h16* a = (const h16*)(ws + WS_ACAT) + (size_t)row * 1536; const h16* w = (const h16*)(ws + WS_WUP) + (size_t)c * 1536;
        const float va = dot_hh(a, w, 512), vs = dot_hh(a + 512, w + 512, 1024);
        const float ga = (float)PROJ[(size_t)row * INC + COL_G + c], gs = (float)PROJ[(size_t)row * INC + COL_G + D + c];
        if (!close_((float)((const h16*)(ws + WS_MERGED))[(size_t)row * D + c], ga * va + gs * vs)) chk_fail(ctl, 11);
    }
    if (after == 6) {
        const int row = r0 % T, c = r1 % D;
        const float v = in[0][(size_t)row * D + c] + dot_hh((const h16*)(ws + WS_MERGED) + (size_t)row * D, (const h16*)(ws + WS_WOUT) + (size_t)c * D, D);
        if (!close_(((const float*)(ws + WS_X1))[(size_t)row * D + c], v)) chk_fail(ctl, 12);
    }
}

__global__ void __launch_bounds__(NWAVES * 64, 2) fwd_kernel(Args args) {
    extern __shared__ __attribute__((aligned(16))) unsigned char lds_raw[];
    Frame F;
    F.lds = (LAS unsigned char*)lds_raw; F.ws = args.ws;
    F.tid = threadIdx.x; F.lane = F.tid & 63; F.wave = __builtin_amdgcn_readfirstlane(F.tid >> 6);
    F.G = gridDim.x; F.gw = blockIdx.x * NWAVES + F.wave; F.NGW = F.G * NWAVES;
    unsigned char* ws = args.ws;
    const float* const* in = args.in;
    volatile LAS unsigned* MISC = (volatile LAS unsigned*)(F.lds + MISC_OFF);
    for (int u = F.tid; u < (LDS_BYTES - LDSCTL_OFF) / 4; u += NWAVES * 64) ((LAS unsigned*)(F.lds + LDSCTL_OFF))[u] = 0u;
    __syncthreads();
    unsigned* ctl = (unsigned*)(ws + WS_CTL);
    XcdBarrier bar; bar.bar = ctl + CW_BAR; bar.x = 0; bar.st = nullptr;
    if (MK_N_LAUNCHES == 1) bar = xcd_barrier_post(ctl + CW_BAR, MISC + 8);
    const int lo = args.ph_lo, hi = args.ph_hi;
#ifndef PH_MASK
#define PH_MASK 0xFFF
#endif
#define IN(k) ((((PH_MASK) >> (k)) & 1) && lo <= (k) && (k) < hi)
#define SEAM(k) do { if (IN(k) && IN((k) + 1)) xcd_barrier(bar); } while (0)
    const int lane = F.lane, wave = F.wave, tid = F.tid;
    if (DBGCHK && args.chk > 0) { if (blockIdx.x == 0) run_checks(args.chk - 1, in, ws, ctl, tid); return; }

    if (IN(0)) {
        LAS float* scr = (LAS float*)(F.lds + wave * 16384);
        const int gw = F.gw, NGW = F.NGW;
        constexpr int I_IN = (D / 64) * (INC / 32), I_GLU = (1024 / 64) * (1024 / 32), I_UA = (512 / 64) * (D / 32), I_US = (1024 / 64) * (D / 32), I_OUT = (D / 64) * (D / 32);
        constexpr int I_EG = (D / 64) * (FF / 32), I_ED = (FF / 64) * (D / 32);
        constexpr int NIT = I_IN + I_GLU + I_UA + I_US + I_OUT + NE * (2 * I_EG + I_ED);
        for (int it = gw; it < NIT; it += NGW) {
            int rr = it;
            if (rr < I_IN) { p0_transpose_item(in[2], INC, (h16*)(ws + WS_WIN), D, 0, 0, scr, rr, lane); continue; } rr -= I_IN;
            if (rr < I_GLU) { p0_transpose_item(in[12], 1024, (h16*)(ws + WS_WGLU), 1024, 0, 0, scr, rr, lane); continue; } rr -= I_GLU;
            if (rr < I_UA) { p0_transpose_item(in[14], D, (h16*)(ws + WS_WUP), 1536, 0, 0, scr, rr, lane); continue; } rr -= I_UA;
            if (rr < I_US) { p0_transpose_item(in[15], D, (h16*)(ws + WS_WUP), 1536, 512, 0, scr, rr, lane); continue; } rr -= I_US;
            if (rr < I_OUT) { p0_transpose_item(in[16], D, (h16*)(ws + WS_WOUT), D, 0, 0, scr, rr, lane); continue; } rr -= I_OUT;
            const int per_e = 2 * I_EG + I_ED, e = rr / per_e; rr -= e * per_e;
            if (rr < I_EG) { p0_transpose_item(in[22] + (size_t)e * D * FF, FF, (h16*)(ws + WS_WGU) + (size_t)e * 1024 * D, D, 0, 0, scr, rr, lane); continue; } rr -= I_EG;
            if (rr < I_EG) { p0_transpose_item(in[23] + (size_t)e * D * FF, FF, (h16*)(ws + WS_WGU) + (size_t)e * 1024 * D, D, 0, 512, scr, rr, lane); continue; } rr -= I_EG;
            p0_transpose_item(in[24] + (size_t)e * FF * D, D, (h16*)(ws + WS_WDN) + (size_t)e * D * FF, FF, 0, 0, scr, rr, lane);
        }
        for (int m = gw; m < T; m += NGW) rms_row_to_h16(in[0] + (size_t)m * D, in[1], (h16*)(ws + WS_H) + (size_t)m * D, lane);
        {
            const int gt = blockIdx.x * (NWAVES * 64) + tid;
            if (gt < 4096) {
                const int g = gt >> 6, p = gt & 63;
                const float are = in[4][gt], aim = in[5][gt], step = expf(in[6][g]);
                const float mag = expf(are * step), ang = aim * step;
                float sn, cs; sincosf(ang, &sn, &cs);
                const float br = mag * cs, bi = mag * sn;
                float pr = br, pi = bi;
#pragma unroll
                for (int k = 0; k < 6; ++k) { const float nr2 = pr * pr - pi * pi, ni2 = 2.f * pr * pi; pr = nr2; pi = ni2; }
                ((f32x4*)(ws + WS_AB))[gt] = (f32x4){br, bi, pr, pi};
                const float nr = br - 1.0f, ni = bi, den = are * are + aim * aim;
                const float fr_ = (nr * are + ni * aim) / den, fi_ = (ni * are - nr * aim) / den;
                h16* BB = (h16*)(ws + WS_BB) + ((size_t)g * 128 + 2 * p) * 16;
                const float* bre = in[7] + (size_t)gt * 16; const float* bim = in[8] + (size_t)gt * 16;
#pragma unroll
                for (int h = 0; h < 16; ++h) { BB[h] = (h16)(fr_ * bre[h] - fi_ * bim[h]); BB[16 + h] = (h16)(fr_ * bim[h] + fi_ * bre[h]); }
                h16* CT = (h16*)(ws + WS_CT) + (size_t)g * 16 * 128 + 2 * p;
#pragma unroll
                for (int h = 0; h < 16; ++h) { CT[h * 128] = (h16)in[9][((size_t)g * 16 + h) * 64 + p]; CT[h * 128 + 1] = (h16)(-in[10][((size_t)g * 16 + h) * 64 + p]); }
            }
        }
        for (int i = blockIdx.x * (NWAVES * 64) + tid; i < D * 64; i += F.G * NWAVES * 64) {
            const int k = i >> 6, j = i & 63; const float gn = in[17][k];
            float v = 0.f; if (j < 32) v = in[20][k * 32 + j] * gn; else if (j < 36) v = in[18][k * 4 + (j - 32)] * gn;
            ((float*)(ws + WS_WR))[i] = v;
        }
    }
    SEAM(0);

    if (IN(1)) {
        pg8::Gemm g{(const h16*)(ws + WS_H), (const h16*)(ws + WS_WIN), D, (size_t)pg8::HALF * D * 2};
        pg8::StaticOrder S; S.init(T, INC, D, F.G, (int)blockIdx.x);
        pg8::EpiProj E{(h16*)(ws + WS_PROJ), in[3]};
        pg8::gemm_phase<pg8::EpiProj, pg8::StaticOrder>(F.lds, g, S, E);
    }
    SEAM(1);

    if (IN(2)) {
#ifndef NO_ATTN
        for (int it = blockIdx.x; it < 768; it += F.G) attn_pair(F, 2 * it);
#endif
#ifndef NO_SSM1
        for (int it = F.gw; it < 8192; it += F.NGW) ssm_item<false>(F, in, it & 63, it >> 6, F.lds + wave * 16384);
#endif
    }
    SEAM(2);

    if (IN(3)) {
        for (int i = blockIdx.x * (NWAVES * 64) + tid; i < T * 64; i += F.G * NWAVES * 64) {
            const int t = i >> 6, hsl = (i >> 3) & 7, c8 = i & 7;
            const float* LSE = (const float*)(ws + WS_LSE);
            const float l0 = LSE[((size_t)0 * T + t) * 8 + hsl], l1 = LSE[((size_t)1 * T + t) * 8 + hsl], l2 = LSE[((size_t)2 * T + t) * 8 + hsl];
            const float m = fmaxf(l0, fmaxf(l1, l2));
            float w0 = __expf(l0 - m), w1 = __expf(l1 - m), w2 = __expf(l2 - m); const float inv = 1.0f / (w0 + w1 + w2); w0 *= inv; w1 *= inv; w2 *= inv;
            const h16* OG = (const h16*)(ws + WS_OG) + (size_t)t * 512 + hsl * 64 + c8 * 8;
            const u32x4 a = *(const u32x4*)OG, b = *(const u32x4*)(OG + (size_t)T * 512), cc = *(const u32x4*)(OG + (size_t)2 * T * 512);
            u32x4 o;
#pragma unroll
            for (int e = 0; e < 4; ++e) {
                const h16x2 ha = pg8::as_h2(a[e]), hb = pg8::as_h2(b[e]), hc = pg8::as_h2(cc[e]);
                o[e] = pk2(w0 * (float)ha.x + w1 * (float)hb.x + w2 * (float)hc.x, w0 * (float)ha.y + w1 * (float)hb.y + w2 * (float)hc.y);
            }
            if (DBG & 1) o = (u32x4){0u, 0u, 0u, 0u};
            *(u32x4*)((h16*)(ws + WS_ACAT) + (size_t)t * 1536 + hsl * 64 + c8 * 8) = o;
        }
        for (int it = F.gw; it < 8192; it += F.NGW) {
            const int g = it & 63, j = it >> 6; const int c = ((j >> 5) & 1) ? ((j & ~31) + 31 - (j & 31)) : j;
            ssm_item<true>(F, in, g, c, F.lds + wave * 16384);
        }
    }
    SEAM(3);

    if (IN(4)) {
        pg8::Gemm g{(const h16*)(ws + WS_YG), (const h16*)(ws + WS_WGLU), 1024, (size_t)pg8::HALF * 1024 * 2};
        pg8::StaticOrder S; S.init(T, 1024, 1024, F.G, (int)blockIdx.x);
        pg8::EpiGlu E{(const h16*)(ws + WS_YG), (h16*)(ws + WS_ACAT), in[13]};
        pg8::gemm_phase<pg8::EpiGlu, pg8::StaticOrder>(F.lds, g, S, E);
    }
    SEAM(4);

    if (IN(5)) {
        pg8::Gemm g{(const h16*)(ws + WS_ACAT), (const h16*)(ws + WS_WUP), 1536, (size_t)pg8::HALF * 1536 * 2};
        pg8::StaticOrder S; S.init(T, D, 1536, F.G, (int)blockIdx.x);
        pg8::EpiUp E{(const h16*)(ws + WS_PROJ), (h16*)(ws + WS_MERGED)};
        pg8::gemm_phase<pg8::EpiUp, pg8::StaticOrder>(F.lds, g, S, E);
    }
    SEAM(5);

    if (IN(6)) {
        pg8::Gemm g{(const h16*)(ws + WS_MERGED), (const h16*)(ws + WS_WOUT), D, (size_t)pg8::HALF * D * 2};
        pg8::StaticOrder S; S.init(T, D, D, F.G, (int)blockIdx.x);
        pg8::EpiOut E{in[0], (float*)(ws + WS_X1)};
        pg8::gemm_phase<pg8::EpiOut, pg8::StaticOrder>(F.lds, g, S, E);
    }
    SEAM(6);

    if (IN(7)) {
        const float* X1 = (const float*)(ws + WS_X1); const float* WR = (const float*)(ws + WS_WR);
        LAS float* part = (LAS float*)F.lds;
        for (int tb = blockIdx.x; tb < T / 32; tb += F.G) {
            const int t0 = tb * 32, i = lane & 31, kk = lane >> 5, kbase = wave * 256;
            f32x16 ae = {0.f, 0.f, 0.f, 0.f, 0.f, 0.f, 0.f, 0.f, 0.f, 0.f, 0.f, 0.f, 0.f, 0.f, 0.f, 0.f}, ag = ae;
            float ss = 0.f;
            const float* xrow = X1 + (size_t)(t0 + i) * D + kbase + 4 * kk;
            for (int m = 0; m < 32; ++m) {
                const f32x4 xv = *(const f32x4*)(xrow + 8 * m);
                ss += (xv.x * xv.x + xv.y * xv.y) + (xv.z * xv.z + xv.w * xv.w);
                const float* wp = WR + (size_t)(kbase + 8 * m + 4 * kk) * 64 + i;
#pragma unroll
                for (int e = 0; e < 4; ++e) {
                    ae = __builtin_amdgcn_mfma_f32_32x32x2f32(xv[e], wp[e * 64], ae, 0, 0, 0);
                    ag = __builtin_amdgcn_mfma_f32_32x32x2f32(xv[e], wp[e * 64 + 32], ag, 0, 0, 0);
                }
            }
            ss += __shfl_xor(ss, 32);
            LAS float* pw = part + wave * (32 * 65);
#pragma unroll
            for (int q = 0; q < 16; ++q) { const int tr = (q & 3) + 8 * (q >> 2) + 4 * kk; pw[tr * 65 + i] = ae[q]; if (i < 4) pw[tr * 65 + 32 + i] = ag[q]; }
            if (kk == 0) pw[i * 65 + 64] = ss;
            __syncthreads();
            if (tid < 32) {
                const int t = t0 + tid; float lg[36]; float sq = 0.f;
#pragma unroll
                for (int j = 0; j < 36; ++j) lg[j] = 0.f;
                for (int w = 0; w < 8; ++w) { const LAS float* p = part + w * (32 * 65) + tid * 65;
#pragma unroll
                    for (int j = 0; j < 36; ++j) lg[j] += p[j];
                    sq += p[64]; }
                const float rs = 1.0f / sqrtf(sq * (1.0f / D) + EPS);
                float gl[4]; int gi = 0; float gm;
#pragma unroll
                for (int j = 0; j < 4; ++j) gl[j] = lg[32 + j] * rs + in[19][j];
                gm = gl[0];
#pragma unroll
                for (int j = 1; j < 4; ++j) if (gl[j] > gm) { gm = gl[j]; gi = j; }
                float gsum = 0.f;
#pragma unroll
                for (int j = 0; j < 4; ++j) gsum += expf(gl[j] - gm);
                const float gp = 1.0f / gsum;
                float el[8];
#pragma unroll
                for (int j = 0; j < 8; ++j) { float v = 0.f;
#pragma unroll
                    for (int q = 0; q < 4; ++q) v = (gi == q) ? lg[q * 8 + j] : v;
                    el[j] = v * rs + in[21][gi * 8 + j]; }
                int j0 = 0; float v0 = el[0];
#pragma unroll
                for (int j = 1; j < 8; ++j) if (el[j] > v0) { v0 = el[j]; j0 = j; }
                int j1 = -1; float v1 = -INFINITY;
#pragma unroll
                for (int j = 0; j < 8; ++j) if (j != j0 && el[j] > v1) { v1 = el[j]; j1 = j; }
                const float e1 = expf(v1 - v0), w0 = gp / (1.0f + e1), w1 = gp * e1 / (1.0f + e1);
                const int ex0 = gi * 8 + j0, ex1 = gi * 8 + j1;
                const int s0 = (int)atomicAdd(ctl + CW_CNT + ex0, 1u), s1 = (int)atomicAdd(ctl + CW_CNT + ex1, 1u);
                ((int4*)(ws + WS_ROUTI))[t] = make_int4(ex0, ex1, s0, s1);
                ((f32x4*)(ws + WS_ROUTF))[t] = (f32x4){w0, w1, rs, 0.f};
            }
            __syncthreads();
        }
    }
    SEAM(7);

    if (IN(8)) {
        LAS int* rb = (LAS int*)F.lds;
        if (tid == 0) {
            int acc = 0; int* te = (int*)(ws + WS_TILEE);
            for (int e = 0; e < NE; ++e) { const int cnt = (int)xb_ld(ctl + CW_CNT + e), ntl = (cnt + 255) >> 8; rb[e] = acc * 256;
                if (blockIdx.x == 0) for (int q = 0; q < ntl; ++q) te[acc + q] = e;
                acc += ntl; }
            if (blockIdx.x == 0) te[127] = acc;
        }
        __syncthreads();
        const float* X1 = (const float*)(ws + WS_X1);
        for (int t = F.gw; t < T; t += F.NGW) {
            const int4 ri = ((const int4*)(ws + WS_ROUTI))[t]; const float rs = ((const f32x4*)(ws + WS_ROUTF))[t].z;
            const int row0 = rb[ri.x] + ri.z, row1 = rb[ri.y] + ri.w;
            const f32x4* xr = (const f32x4*)(X1 + (size_t)t * D) + lane; const f32x4* gr = (const f32x4*)in[17] + lane;
            u32x2* o0 = (u32x2*)((h16*)(ws + WS_XS) + (size_t)row0 * D) + lane; u32x2* o1 = (u32x2*)((h16*)(ws + WS_XS) + (size_t)row1 * D) + lane;
#pragma unroll
            for (int j = 0; j < 8; ++j) { const f32x4 v = xr[64 * j], gn = gr[64 * j]; u32x2 w; w.x = pk2(v.x * rs * gn.x, v.y * rs * gn.y); w.y = pk2(v.z * rs * gn.z, v.w * rs * gn.w); o0[64 * j] = w; o1[64 * j] = w; }
            if (lane == 0) ((int2*)(ws + WS_TOKROW))[t] = make_int2(row0, row1);
        }
    }
    SEAM(8);

    if (IN(9)) {
        pg8::Gemm g{(const h16*)(ws + WS_XS), (const h16*)(ws + WS_WGU), D, (size_t)512 * D * 2};
        pg8::ExpertOrder S{(const int*)(ws + WS_TILEE), 4, F.G, (int)blockIdx.x, (size_t)1024 * D * 2, (size_t)pg8::HALF * D * 2};
        pg8::EpiGateUp E{(h16*)(ws + WS_HID)};
        pg8::gemm_phase<pg8::EpiGateUp, pg8::ExpertOrder>(F.lds, g, S, E);
    }
    SEAM(9);

    if (IN(10)) {
        pg8::Gemm g{(const h16*)(ws + WS_HID), (const h16*)(ws + WS_WDN), FF, (size_t)pg8::HALF * FF * 2};
        pg8::ExpertOrder S{(const int*)(ws + WS_TILEE), 8, F.G, (int)blockIdx.x, (size_t)D * FF * 2, (size_t)pg8::BM * FF * 2};
        pg8::EpiDown E{(h16*)(ws + WS_Y)};
        pg8::gemm_phase<pg8::EpiDown, pg8::ExpertOrder>(F.lds, g, S, E);
    }
    SEAM(10);

    if (IN(11)) {
        const float* X1 = (const float*)(ws + WS_X1); const h16* Y = (const h16*)(ws + WS_Y);
        for (int t = F.gw; t < T; t += F.NGW) {
            const int2 tr = ((const int2*)(ws + WS_TOKROW))[t]; const f32x4 rf = ((const f32x4*)(ws + WS_ROUTF))[t];
            const f32x4* xr = (const f32x4*)(X1 + (size_t)t * D) + lane;
            const u32x2* y0 = (const u32x2*)(Y + (size_t)tr.x * D) + lane; const u32x2* y1 = (const u32x2*)(Y + (size_t)tr.y * D) + lane;
            f32x4 v[8]; float s = 0.f;
#pragma unroll
            for (int j = 0; j < 8; ++j) { const f32x4 a = pg8::h4_to_f4(y0[64 * j]), b = pg8::h4_to_f4(y1[64 * j]); v[j] = (DBG & 4) ? xr[64 * j] : xr[64 * j] + rf.x * a + rf.y * b;
                s += (v[j].x * v[j].x + v[j].y * v[j].y) + (v[j].z * v[j].z + v[j].w * v[j].w); }
            const float r = 1.0f / sqrtf(wave_sum(s) * (1.0f / D) + EPS);
            const f32x4* gr = (const f32x4*)in[25] + lane; f32x4* orow = (f32x4*)(args.out + (size_t)t * D) + lane;
#pragma unroll
            for (int j = 0; j < 8; ++j) orow[64 * j] = v[j] * r * gr[64 * j];
            if (DBGCHK) {
                const unsigned dv = xb_ld(ctl + CW_DBG); const int code = dv ? 100 - (int)dv : 0;
                const float tab[13] = {1.f, 0.f, 0.5f, 2.f, 3.f, 4.f, 6.f, 10.f, 16.f, 30.f, 60.f, 120.f, 250.f};
                float sc = 1.f;
#pragma unroll
                for (int q = 0; q < 13; ++q) sc = (code == q) ? tab[q] : sc;
                if (code == 8) sc = 2.0f + 10.0f * (float)xb_ld(ctl + CW_DBG + 1) / 512.0f + 100.0f * (float)xb_ld(ctl + CW_DBG + 2) / 512.0f;
                const f32x4* x0 = (const f32x4*)(in[0] + (size_t)t * D) + lane; f32x4 xv[8]; float s2 = 0.f;
#pragma unroll
                for (int j = 0; j < 8; ++j) { xv[j] = x0[64 * j]; s2 += (xv[j].x * xv[j].x + xv[j].y * xv[j].y) + (xv[j].z * xv[j].z + xv[j].w * xv[j].w); }
                const float r2 = 1.0f / sqrtf(wave_sum(s2) * (1.0f / D) + EPS);
#pragma unroll
                for (int j = 0; j < 8; ++j) orow[64 * j] = xv[j] * (r2 * sc) * gr[64 * j];
            }
        }
    }
#undef IN
#undef SEAM
}

extern "C" void kernel_launch(void* const* d_in, const int* in_sizes, int n_in, void* d_out, int out_size, void* d_ws, size_t ws_size, hipStream_t stream) {
    static int grid = 0;
    if (grid == 0) {
        if (n_in != 26 || in_sizes[0] != T * D || out_size != T * D || ws_size < WS_END) { fprintf(stderr, "kernel_launch: unexpected shapes (n_in %d, in0 %d, out %d, ws %zu); nothing launched\n", n_in, n_in > 0 ? in_sizes[0] : -1, out_size, ws_size); grid = -1; return; }
        int dev = 0, cus = 0, per_cu = 0;
        if (hipGetDevice(&dev) != hipSuccess || hipDeviceGetAttribute(&cus, hipDeviceAttributeMultiprocessorCount, dev) != hipSuccess) { fprintf(stderr, "kernel_launch: device query failed\n"); grid = -1; return; }
        if (hipFuncSetAttribute((const void*)fwd_kernel, hipFuncAttributeMaxDynamicSharedMemorySize, LDS_BYTES) != hipSuccess) { fprintf(stderr, "kernel_launch: hipFuncSetAttribute failed\n"); grid = -1; return; }
        if (hipOccupancyMaxActiveBlocksPerMultiprocessor(&per_cu, (const void*)fwd_kernel, NWAVES * 64, LDS_BYTES) != hipSuccess || per_cu < 1) { fprintf(stderr, "kernel_launch: occupancy query reports %d workgroups per CU\n", per_cu); per_cu = 1; }
        (void)hipGetLastError();
        grid = cus;
    }
    if (grid < 0) return;
    if (hipMemsetAsync((char*)d_ws + WS_CTL, 0, CTL_ZERO_BYTES, stream) != hipSuccess) { fprintf(stderr, "kernel_launch: hipMemsetAsync failed\n"); return; }
    Args a{};
    for (int i = 0; i < 26; ++i) a.in[i] = (const float*)d_in[i];
    a.out = (float*)d_out; a.ws = (unsigned char*)d_ws;
    for (int li = 0; li < MK_N_LAUNCHES; ++li) {
        if (MK_N_LAUNCHES == 1) { a.ph_lo = 0; a.ph_hi = 12; } else { a.ph_lo = li; a.ph_hi = li + 1; }
        hipLaunchKernelGGL(fwd_kernel, dim3(grid), dim3(NWAVES * 64), LDS_BYTES, stream, a);
        const hipError_t le = hipPeekAtLastError();
        if (le != hipSuccess) { fprintf(stderr, "kernel_launch: launch %d failed: %s\n", li, hipGetErrorName(le)); break; }
        if (DBGCHK && MK_N_LAUNCHES > 1 && li <= 6) { Args c = a; c.ph_lo = 0; c.ph_hi = 0; c.chk = li + 1; hipLaunchKernelGGL(fwd_kernel, dim3(8), dim3(NWAVES * 64), LDS_BYTES, stream, c); }
    }
}
```

```cpp
#include <hip/hip_runtime.h>
#include <cstdio>
#include <cstdint>

#ifndef MK_N_LAUNCHES
#define MK_N_LAUNCHES 1
#endif

#ifndef DBG
#define DBG 0
#endif
#define LAS __attribute__((address_space(3)))
#define GAS __attribute__((address_space(1)))
typedef _Float16 h16;
typedef _Float16 h16x8 __attribute__((ext_vector_type(8)));
typedef _Float16 h16x4 __attribute__((ext_vector_type(4)));
typedef _Float16 h16x2 __attribute__((ext_vector_type(2)));
typedef float f32x2 __attribute__((ext_vector_type(2)));
typedef float f32x4 __attribute__((ext_vector_type(4)));
typedef float f32x16 __attribute__((ext_vector_type(16)));
typedef unsigned u32x2 __attribute__((ext_vector_type(2)));
typedef unsigned u32x4 __attribute__((ext_vector_type(4)));
typedef short s16x4 __attribute__((ext_vector_type(4)));

constexpr int T = 8192, D = 2048;
constexpr int QKV = 1536, SSMW = 1024, INC = 9728;
constexpr int COL_K = 1536, COL_V = 3072, COL_U = 4608, COL_G = 5632;
constexpr int NE = 32, FF = 512;
constexpr float EPS = 1e-6f;
constexpr float LOG2E = 1.4426950408889634f, LN2 = 0.6931471805599453f;

constexpr size_t MiB = 1u << 20;
constexpr size_t WS_CTL = 0, CTL_ZERO_BYTES = 64 * 1024;
constexpr size_t WS_AB = 1 * MiB;
constexpr size_t WS_BB = WS_AB + 256 * 1024;
constexpr size_t WS_CT = WS_BB + 256 * 1024;
constexpr size_t WS_LSE = 2 * MiB;
constexpr size_t WS_ROUTI = 3 * MiB;
constexpr size_t WS_ROUTF = WS_ROUTI + 128 * 1024;
constexpr size_t WS_TOKROW = WS_ROUTF + 128 * 1024;
constexpr size_t WS_TILEE = WS_TOKROW + 64 * 1024;
constexpr size_t WS_WR = 4 * MiB;
constexpr size_t WS_S = 8 * MiB;
constexpr size_t WS_WIN = 12 * MiB;
constexpr size_t WS_H = 50 * MiB;
constexpr size_t WS_X1 = 12 * MiB;
constexpr size_t WS_WGLU = 82 * MiB;
constexpr size_t WS_WUP = 84 * MiB;
constexpr size_t WS_WOUT = 90 * MiB;
constexpr size_t WS_WGU = 98 * MiB;
constexpr size_t WS_WDN = 226 * MiB;
constexpr size_t WS_PROJ = 290 * MiB;
constexpr size_t WS_OG = 442 * MiB;
constexpr size_t WS_YG = 466 * MiB;
constexpr size_t WS_ACAT = 482 * MiB;
constexpr size_t WS_MERGED = 442 * MiB;
constexpr size_t WS_XS = 290 * MiB;
constexpr size_t WS_HID = 386 * MiB;
constexpr size_t WS_Y = 410 * MiB;
constexpr size_t WS_END = 506 * MiB;
constexpr int MAXTILES = 96;
constexpr int CAP = 768, CAPT = CAP / 256;
constexpr size_t WS_OVF = WS_TILEE + 4096;
constexpr int MAXOVF = 2 * T;
constexpr int CW_BAR = 4096;
constexpr int CW_CNT = 8192;
constexpr int CW_OVF = 8192 + 64;

namespace pg8 {
constexpr int BM = 256, BK = 64, HALF = 128, HTB = HALF * BK * 2, STAGE_BYTES = 8 * HTB, NXCD = 8, WGM = 8;
__host__ __device__ __forceinline__ int lds_byte(int r, int c) { const int st = (r >> 4) * 2 + (c >> 5), rr = r & 15, cc = c & 31, ob = rr * 64 + cc * 2; return st * 1024 + (ob ^ (((ob >> 9) & 1) << 5)); }
__host__ __device__ __forceinline__ void stage_rc(int b, int& R, int& C) { const int st = b / 1024, sb = b % 1024, swz = sb ^ (((sb >> 9) & 1) << 5); R = (st >> 1) * 16 + swz / 64; C = (st & 1) * 32 + (swz % 64) / 2; }
__host__ __device__ __forceinline__ int perm32(int rho) { const int n = rho >> 4, i = rho & 15; return 8 * (i >> 2) + 4 * n + (i & 3); }

struct Unit { int pm, pn; size_t boff; int half; };
struct Gemm { const h16* A; const h16* Bt; int K; size_t b_hstep; };

struct StaticOrder {
    int nM, nN, nwg, G, c, K;
    __device__ void init(int M, int N, int K_, int G_, int c_) { nM = M / BM; nN = N / BM; nwg = nM * nN; G = G_; c = c_; K = K_; }
    __device__ bool next(int i, Unit& u) const {
        const long L = (long)i * G + c; if (L >= nwg) return false;
        int wgid = (int)L; { const int q = nwg / NXCD, r = nwg % NXCD, xcd = wgid % NXCD, off = wgid / NXCD; wgid = (xcd < r ? xcd * (q + 1) : r * (q + 1) + (xcd - r) * q) + off; }
        const int nig = WGM * nN, gid = wgid / nig, fm = gid * WGM, gsz = (nM - fm) < WGM ? (nM - fm) : WGM;
        u.pm = fm + ((wgid % nig) % gsz); u.pn = (wgid % nig) / gsz; u.boff = (size_t)u.pn * BM * K * 2; u.half = 0; return true;
    }
};
struct ExpertOrder {
    const LAS int* tl; int NT, G, c; size_t e_bytes, pn_bytes;
    __device__ bool next(int i, Unit& u) const {
        const int x = c & 7, off = i * (G >> 3) + (c >> 3), ti = off / NT; if (ti >= tl[8 + x]) return false;
        const int ent = tl[16 + tl[x] + ti]; u.pm = ent & 0xffff; u.half = ent >> 16; u.pn = off % NT;
        const int e = u.pm / CAPT; u.boff = (size_t)e * e_bytes + (size_t)u.pn * pn_bytes; return true;
    }
};
__device__ __forceinline__ unsigned pk2(float lo, float hi) { f32x2 v = {lo, hi}; h16x2 h = __builtin_convertvector(v, h16x2); return __builtin_bit_cast(unsigned, h); }
__device__ __forceinline__ float sigmoidf_(float x) { return __builtin_amdgcn_rcpf(1.0f + __builtin_amdgcn_exp2f(-x * LOG2E)); }
__device__ __forceinline__ h16x2 as_h2(unsigned u) { return __builtin_bit_cast(h16x2, u); }
__device__ __forceinline__ f32x4 h4_to_f4(u32x2 w) { const h16x2 a = as_h2(w.x), b = as_h2(w.y); return (f32x4){(float)a.x, (float)a.y, (float)b.x, (float)b.y}; }

typedef f32x4 Acc[2][2][4][2];

struct EpiProj {
    static constexpr bool PERM = true; static constexpr int HOOK_T = -1;
    h16* O; const float* bgate;
    __device__ __forceinline__ void mid(Acc&, const Unit&, int, int, int, int) const {}
    __device__ __forceinline__ void operator()(const Acc& acc, const Unit& u, int wr, int wc, int fr, int fq) const {
        const int row0 = u.pm * BM + wr * 64 + fr, col0 = u.pn * BM + wc * 32 + 8 * fq; const bool isg = col0 >= COL_G;
#pragma unroll
        for (int bj = 0; bj < 2; ++bj) {
            f32x4 b0 = {0.f, 0.f, 0.f, 0.f}, b1 = b0;
            if (isg) { b0 = *(const f32x4*)(bgate + col0 - COL_G + bj * HALF); b1 = *(const f32x4*)(bgate + col0 - COL_G + bj * HALF + 4); }
#pragma unroll
            for (int ai = 0; ai < 2; ++ai)
#pragma unroll
                for (int m = 0; m < 4; ++m) {
                    f32x4 v0 = acc[ai][bj][m][0], v1 = acc[ai][bj][m][1];
                    if (isg) { v0 += b0; v1 += b1;
#pragma unroll
                        for (int e = 0; e < 4; ++e) { v0[e] = sigmoidf_(v0[e]); v1[e] = sigmoidf_(v1[e]); } }
                    u32x4 w; w.x = pk2(v0[0], v0[1]); w.y = pk2(v0[2], v0[3]); w.z = pk2(v1[0], v1[1]); w.w = pk2(v1[2], v1[3]);
                    *(u32x4*)(O + (size_t)(row0 + ai * HALF + m * 16) * INC + col0 + bj * HALF) = w; }
        }
    }
};
struct EpiGlu {
    static constexpr bool PERM = true; static constexpr int HOOK_T = -1;
    const h16* YG; h16* ACAT; const float* bglu;
    __device__ __forceinline__ void mid(Acc&, const Unit&, int, int, int, int) const {}
    __device__ __forceinline__ void operator()(const Acc& acc, const Unit& u, int wr, int wc, int fr, int fq) const {
        const int row0 = u.pm * BM + wr * 64 + fr, col0 = u.pn * BM + wc * 32 + 8 * fq;
#pragma unroll
        for (int bj = 0; bj < 2; ++bj) {
            const f32x4 b0 = *(const f32x4*)(bglu + col0 + bj * HALF), b1 = *(const f32x4*)(bglu + col0 + bj * HALF + 4);
#pragma unroll
            for (int ai = 0; ai < 2; ++ai)
#pragma unroll
                for (int m = 0; m < 4; ++m) {
                    const size_t r = (size_t)(row0 + ai * HALF + m * 16);
                    const u32x4 yw = *(const u32x4*)(YG + r * SSMW + col0 + bj * HALF);
                    const f32x4 y0 = h4_to_f4((u32x2){yw.x, yw.y}), y1 = h4_to_f4((u32x2){yw.z, yw.w});
                    f32x4 v0 = acc[ai][bj][m][0] + b0, v1 = acc[ai][bj][m][1] + b1;
#pragma unroll
                    for (int e = 0; e < 4; ++e) { v0[e] = y0[e] * sigmoidf_(v0[e]); v1[e] = y1[e] * sigmoidf_(v1[e]); }
                    u32x4 w; w.x = pk2(v0[0], v0[1]); w.y = pk2(v0[2], v0[3]); w.z = pk2(v1[0], v1[1]); w.w = pk2(v1[2], v1[3]);
                    if (DBG & 2) w = (u32x4){0u, 0u, 0u, 0u};
                    *(u32x4*)(ACAT + r * 1536 + 512 + col0 + bj * HALF) = w; }
        }
    }
};
struct EpiUp {
    static constexpr bool PERM = true; static constexpr int HOOK_T = 8;
    const h16* PROJ; h16* O;
    __device__ __forceinline__ void mid(Acc& acc, const Unit& u, int wr, int wc, int fr, int fq) const {
        int row0 = u.pm * BM + wr * 64 + fr, col0 = u.pn * BM + wc * 32 + 8 * fq;
        asm volatile("" : "+v"(row0), "+v"(col0));
#pragma unroll
        for (int ai = 0; ai < 2; ++ai)
#pragma unroll
            for (int m = 0; m < 4; ++m)
#pragma unroll
                for (int bj = 0; bj < 2; ++bj) {
                    const h16* gp = PROJ + (size_t)(row0 + ai * HALF + m * 16) * INC + COL_G + col0 + bj * HALF;
                    const u32x4 ga = *(const u32x4*)gp, gs = *(const u32x4*)(gp + D);
                    const f32x4 a0 = h4_to_f4((u32x2){ga.x, ga.y}), a1 = h4_to_f4((u32x2){ga.z, ga.w}), s0 = h4_to_f4((u32x2){gs.x, gs.y}), s1 = h4_to_f4((u32x2){gs.z, gs.w});
#pragma unroll
                    for (int e = 0; e < 4; ++e) { acc[ai][bj][m][0][e] *= a0[e] * __builtin_amdgcn_rcpf(s0[e]); acc[ai][bj][m][1][e] *= a1[e] * __builtin_amdgcn_rcpf(s1[e]); }
                    asm volatile("" : "+v"(acc[ai][bj][m][0]), "+v"(acc[ai][bj][m][1]) :: "memory");
                }
    }
    __device__ __forceinline__ void operator()(const Acc& acc, const Unit& u, int wr, int wc, int fr, int fq) const {
        const int row0 = u.pm * BM + wr * 64 + fr, col0 = u.pn * BM + wc * 32 + 8 * fq;
#pragma unroll
        for (int ai = 0; ai < 2; ++ai)
#pragma unroll
            for (int m = 0; m < 4; ++m)
#pragma unroll
                for (int bj = 0; bj < 2; ++bj) {
                    const size_t r = (size_t)(row0 + ai * HALF + m * 16);
                    const u32x4 gs = *(const u32x4*)(PROJ + r * INC + COL_G + D + col0 + bj * HALF);
                    const f32x4 s0 = h4_to_f4((u32x2){gs.x, gs.y}), s1 = h4_to_f4((u32x2){gs.z, gs.w});
                    const f32x4 v0 = acc[ai][bj][m][0] * s0, v1 = acc[ai][bj][m][1] * s1;
                    u32x4 w; w.x = pk2(v0[0], v0[1]); w.y = pk2(v0[2], v0[3]); w.z = pk2(v1[0], v1[1]); w.w = pk2(v1[2], v1[3]);
                    *(u32x4*)(O + r * D + col0 + bj * HALF) = w; asm volatile("" ::: "memory"); }
    }
};
struct EpiOut {
    static constexpr bool PERM = false; static constexpr int HOOK_T = -1;
    const float* X; float* X1;
    __device__ __forceinline__ void mid(Acc&, const Unit&, int, int, int, int) const {}
    __device__ __forceinline__ void operator()(const Acc& acc, const Unit& u, int wr, int wc, int fr, int fq) const {
        const int row0 = u.pm * BM + wr * 64 + fr, col0 = u.pn * BM + wc * 32 + 4 * fq;
#pragma unroll
        for (int ai = 0; ai < 2; ++ai)
#pragma unroll
            for (int m = 0; m < 4; ++m) { const size_t off = (size_t)(row0 + ai * HALF + m * 16) * D + col0;
#pragma unroll
                for (int bj = 0; bj < 2; ++bj)
#pragma unroll
                    for (int n = 0; n < 2; ++n) *(f32x4*)(X1 + off + bj * HALF + n * 16) = *(const f32x4*)(X + off + bj * HALF + n * 16) + acc[ai][bj][m][n]; }
    }
};
struct EpiGateUp {
    static constexpr bool PERM = true; static constexpr int HOOK_T = -1;
    h16* HID;
    __device__ __forceinline__ void mid(Acc&, const Unit&, int, int, int, int) const {}
    __device__ __forceinline__ void operator()(const Acc& acc, const Unit& u, int wr, int wc, int fr, int fq) const {
        const int row0 = u.pm * BM + wr * 64 + fr, col0 = u.pn * HALF + wc * 32 + 8 * fq;
#pragma unroll
        for (int ai = 0; ai < 2; ++ai) if (ai == 0 || !u.half)
#pragma unroll
            for (int m = 0; m < 4; ++m) {
                f32x4 v[2];
#pragma unroll
                for (int n = 0; n < 2; ++n)
#pragma unroll
                    for (int e = 0; e < 4; ++e) { const float g = acc[ai][0][m][n][e]; v[n][e] = g * sigmoidf_(g) * acc[ai][1][m][n][e]; }
                u32x4 w; w.x = pk2(v[0][0], v[0][1]); w.y = pk2(v[0][2], v[0][3]); w.z = pk2(v[1][0], v[1][1]); w.w = pk2(v[1][2], v[1][3]);
                *(u32x4*)(HID + (size_t)(row0 + ai * HALF + m * 16) * FF + col0) = w; }
    }
};
struct EpiDown {
    static constexpr bool PERM = true; static constexpr int HOOK_T = -1;
    h16* Y;
    __device__ __forceinline__ void mid(Acc&, const Unit&, int, int, int, int) const {}
    __device__ __forceinline__ void operator()(const Acc& acc, const Unit& u, int wr, int wc, int fr, int fq) const {
        const int row0 = u.pm * BM + wr * 64 + fr, col0 = u.pn * BM + wc * 32 + 8 * fq;
#pragma unroll
        for (int ai = 0; ai < 2; ++ai) if (ai == 0 || !u.half)
#pragma unroll
            for (int m = 0; m < 4; ++m)
#pragma unroll
                for (int bj = 0; bj < 2; ++bj) {
                    const f32x4 v0 = acc[ai][bj][m][0], v1 = acc[ai][bj][m][1];
                    u32x4 w; w.x = pk2(v0[0], v0[1]); w.y = pk2(v0[2], v0[3]); w.z = pk2(v1[0], v1[1]); w.w = pk2(v1[2], v1[3]);
                    *(u32x4*)(Y + (size_t)(row0 + ai * HALF + m * 16) * D + col0 + bj * HALF) = w; }
    }
};

template <class Epi, class Sched, bool ALIGN_EPI = true, bool HALFSKIP = false>
__device__ __forceinline__ void gemm_phase(LAS unsigned char* lds, const Gemm g, const Sched& S, const Epi& E) {
    const int tid = threadIdx.x, wid = __builtin_amdgcn_readfirstlane(tid >> 6), lane = tid & 63, wr = wid >> 2, wc = wid & 3, fr = lane & 15, fq = lane >> 4;
    const int K = g.K, nt = K / BK;
    unsigned voffA[2], voffB[2];
#pragma unroll
    for (int i = 0; i < 2; ++i) { int R, C; stage_rc(tid * 16 + i * 8192, R, C); const int Rb = Epi::PERM ? ((R & ~31) + perm32(R & 31)) : R;
        voffA[i] = (unsigned)(R * K + C) * 2u; voffB[i] = (unsigned)(Rb * K + C) * 2u; }
    const size_t kstep = (size_t)(BK * 2);
    const size_t hstepA = (size_t)HALF * K * 2, hstepB = g.b_hstep;
    const size_t tstepA = 2 * hstepA;
    const unsigned ldsw = (unsigned)wid * 1024u;
    const int aoff = lds_byte(wr * 64 + fr, fq * 8), boff = lds_byte(wc * 32 + fr, fq * 8);
#define PG8_SA(b, h) (((b) * 2 + (h)) * HTB)
#define PG8_SB(b, h) ((4 + (b) * 2 + (h)) * HTB)
#define PG8_STAGE(bufoff, gbase, voff) do { _Pragma("unroll") for (int _i = 0; _i < 2; ++_i) \
        __builtin_amdgcn_global_load_lds((const unsigned*)((const char*)(gbase) + (voff)[_i]), (LAS unsigned*)(lds + (bufoff) + ldsw + _i * 8192), 16, 0, 0); } while (0)
#define PG8_LDA(dst, b, h) do { _Pragma("unroll") for (int m = 0; m < 4; ++m) _Pragma("unroll") for (int k = 0; k < 2; ++k) dst[m][k] = *(const LAS h16x8*)(lds + PG8_SA(b, h) + aoff + m * 2048 + k * 1024); } while (0)
#define PG8_LDB(dst, b, h) do { _Pragma("unroll") for (int n = 0; n < 2; ++n) _Pragma("unroll") for (int k = 0; k < 2; ++k) dst[n][k] = *(const LAS h16x8*)(lds + PG8_SB(b, h) + boff + n * 2048 + k * 1024); } while (0)
#define PG8_MMA(ai, bj, At, Bt) do { __builtin_amdgcn_s_setprio(1); _Pragma("unroll") for (int m = 0; m < 4; ++m) _Pragma("unroll") for (int n = 0; n < 2; ++n) _Pragma("unroll") for (int k = 0; k < 2; ++k) \
        acc[ai][bj][m][n] = __builtin_amdgcn_mfma_f32_16x16x32_f16(Bt[n][k], At[m][k], acc[ai][bj][m][n], 0, 0, 0); __builtin_amdgcn_s_setprio(0); } while (0)
#define PG8_WAIT_V(n) asm volatile("s_waitcnt vmcnt(" #n ")" ::: "memory")
#define PG8_WAIT_L(n) asm volatile("s_waitcnt lgkmcnt(" #n ")" ::: "memory")
#define PG8_BAR __builtin_amdgcn_s_barrier()
#define PG8_SCHED __builtin_amdgcn_sched_barrier(0)
    Unit cur, nxt; int ui = 0;
    if (!S.next(0, cur)) return;
    Acc acc;
#pragma unroll
    for (int a = 0; a < 2; ++a)
#pragma unroll
        for (int b = 0; b < 2; ++b)
#pragma unroll
            for (int m = 0; m < 4; ++m)
#pragma unroll
                for (int n = 0; n < 2; ++n) acc[a][b][m][n] = (f32x4){0.f, 0.f, 0.f, 0.f};
    h16x8 At[4][2], B0[2][2], B1[2][2];
    const char* cA = (const char*)g.A + (size_t)cur.pm * tstepA; const char* cB = (const char*)g.Bt + cur.boff;
    PG8_STAGE(PG8_SB(0, 0), cB, voffB); PG8_STAGE(PG8_SB(0, 1), cB + hstepB, voffB); PG8_STAGE(PG8_SA(0, 0), cA, voffA); PG8_STAGE(PG8_SA(0, 1), cA + hstepA, voffA);
    if (wr == 1) PG8_BAR;
    PG8_WAIT_V(2); PG8_BAR;
    PG8_STAGE(PG8_SB(1, 0), cB + kstep, voffB); PG8_STAGE(PG8_SA(1, 0), cA + kstep, voffA); PG8_STAGE(PG8_SB(1, 1), cB + hstepB + kstep, voffB);
    PG8_WAIT_V(6); PG8_BAR;
    for (;;) {
        const bool has_next = S.next(ui + 1, nxt);
        const bool hf = HALFSKIP && __builtin_amdgcn_readfirstlane(cur.half) != 0;
        const char* nA = has_next ? (const char*)g.A + (size_t)nxt.pm * tstepA : cA; const char* nB = has_next ? (const char*)g.Bt + nxt.boff : cB;
        for (int t = 0; t < nt; t += 2) {
            if (Epi::HOOK_T >= 0 && t == Epi::HOOK_T) E.mid(acc, cur, wr, wc, fr, fq);
            const bool last = (t == nt - 2);
            const char* a1 = cA + (size_t)(t + 1) * kstep;
            const char* a2 = last ? nA : cA + (size_t)(t + 2) * kstep; const char* b2 = last ? nB : cB + (size_t)(t + 2) * kstep;
            const char* a3 = a2 + kstep; const char* b3 = b2 + kstep;
            PG8_LDB(B0, 0, 0); PG8_LDB(B1, 0, 1); PG8_SCHED; PG8_LDA(At, 0, 0); PG8_STAGE(PG8_SA(1, 1), a1 + hstepA, voffA);
            PG8_WAIT_V(8); PG8_WAIT_L(0); PG8_BAR; PG8_MMA(0, 0, At, B0); PG8_MMA(0, 1, At, B1); PG8_BAR; PG8_SCHED;
            if (!hf) PG8_LDA(At, 0, 1); PG8_STAGE(PG8_SB(0, 0), b2, voffB); PG8_STAGE(PG8_SB(0, 1), b2 + hstepB, voffB); PG8_STAGE(PG8_SA(0, 0), a2, voffA);
            PG8_WAIT_V(8); PG8_WAIT_L(0); PG8_BAR; if (!hf) { PG8_MMA(1, 0, At, B0); PG8_MMA(1, 1, At, B1); } PG8_BAR; PG8_SCHED;
            PG8_LDB(B0, 1, 0); PG8_LDB(B1, 1, 1); PG8_SCHED; PG8_LDA(At, 1, 0); PG8_STAGE(PG8_SA(0, 1), a2 + hstepA, voffA);
            PG8_WAIT_V(8); PG8_WAIT_L(0); PG8_BAR; PG8_MMA(0, 0, At, B0); PG8_MMA(0, 1, At, B1); PG8_BAR; PG8_SCHED;
            if (!hf) PG8_LDA(At, 1, 1); PG8_STAGE(PG8_SB(1, 0), b3, voffB); PG8_STAGE(PG8_SB(1, 1), b3 + hstepB, voffB); PG8_STAGE(PG8_SA(1, 0), a3, voffA);
            PG8_WAIT_V(8); PG8_WAIT_L(0); PG8_BAR; if (!hf) { PG8_MMA(1, 0, At, B0); PG8_MMA(1, 1, At, B1); } PG8_BAR; PG8_SCHED;
        }
        if constexpr (ALIGN_EPI) { if (wr == 0) PG8_BAR; }
        E(acc, cur, wr, wc, fr, fq);
        if (!has_next) break;
#pragma unroll
        for (int a = 0; a < 2; ++a)
#pragma unroll
            for (int b = 0; b < 2; ++b)
#pragma unroll
                for (int m = 0; m < 4; ++m)
#pragma unroll
                    for (int n = 0; n < 2; ++n) acc[a][b][m][n] = (f32x4){0.f, 0.f, 0.f, 0.f};
        cur = nxt; cA = nA; cB = nB; ++ui;
        if constexpr (ALIGN_EPI) { if (wr == 1) PG8_BAR; }
    }
    PG8_WAIT_V(0);
    if constexpr (!ALIGN_EPI) { if (wr == 0) PG8_BAR; }
    PG8_BAR;
#undef PG8_SA
#undef PG8_SB
#undef PG8_STAGE
#undef PG8_LDA
#undef PG8_LDB
#undef PG8_MMA
#undef PG8_WAIT_V
#undef PG8_WAIT_L
#undef PG8_BAR
#undef PG8_SCHED
}
}
using pg8::pk2;

constexpr int NWAVES = 8;
constexpr int RING_BYTES = 131072;
constexpr int LDSCTL_OFF = RING_BYTES, MISC_OFF = LDSCTL_OFF + 320;
constexpr int LDS_BYTES = 147456;

typedef GAS unsigned gu32;
#define RLX_AGENT __ATOMIC_RELAXED, __HIP_MEMORY_SCOPE_AGENT
#define XB_TMO      128
#define XB_XCNT(j)  (256  + 64 * (j))
#define XB_XSUB(j)  (1280 + 64 * (j))
#define XB_XGEN(j)  (2304 + 64 * (j))
#define XB_TOP      3328
#define XB_TOPGEN   3392
#define XCD_BAR_WORDS 3456
#define XB_SPIN_CAP (1u << 18)
__device__ __forceinline__ unsigned xb_ld(unsigned* p)              { return __hip_atomic_load(p, __ATOMIC_RELAXED, __HIP_MEMORY_SCOPE_AGENT); }
__device__ __forceinline__ unsigned xb_add(unsigned* p, unsigned v) { return __hip_atomic_fetch_add(p, v, __ATOMIC_RELAXED, __HIP_MEMORY_SCOPE_AGENT); }
__device__ __forceinline__ unsigned xb_xcc_id() { return (unsigned)__builtin_amdgcn_s_getreg((3 << 11) | 20) & 0xFu; }
#define XB_SPIN(cond, bar) do { unsigned _sp = 0; while (cond) { __builtin_amdgcn_s_sleep(1); \
    if ((++_sp & 255u) == 0u) { if (xb_ld(&(bar)[XB_TMO])) break; if (_sp > XB_SPIN_CAP) { atomicAdd(&(bar)[XB_TMO], 1u); break; } } } } while (0)
struct XcdBarrier { unsigned* bar; unsigned x; volatile LAS unsigned* st; };
__device__ __forceinline__ XcdBarrier xcd_barrier_post(unsigned* bar, volatile LAS unsigned* st) {
    XcdBarrier b; b.bar = bar; b.x = xb_xcc_id(); b.st = st;
    if (threadIdx.x == 0) (void)xb_add(&bar[XB_XCNT(b.x)], 1u);
    return b;
}
__device__ __forceinline__ void xcd_barrier_complete(unsigned* bar, unsigned x, unsigned& nloc, unsigned& nx) {
    const unsigned G = gridDim.x * gridDim.y * gridDim.z;
    unsigned sum, cnt, mine, sp = 0u;
    for (;;) {
        sum = 0u; cnt = 0u; mine = 0u;
#pragma unroll
        for (unsigned j = 0; j < 16; ++j) { const unsigned c = xb_ld(&bar[XB_XCNT(j)]); sum += c; cnt += (c > 0u) ? 1u : 0u; mine = (j == x) ? c : mine; }
        if (sum == G) break;
        __builtin_amdgcn_s_sleep(1);
        if ((++sp & 255u) == 0u) { if (xb_ld(&bar[XB_TMO])) break; if (sp > XB_SPIN_CAP) { atomicAdd(&bar[XB_TMO], 1u); break; } }
    }
    nloc = mine > 0u ? mine : 1u; nx = cnt > 0u ? cnt : 1u;
}
__device__ __forceinline__ void xcd_barrier(const XcdBarrier& b) {
    asm volatile("s_waitcnt vmcnt(0)" ::: "memory");
    __syncthreads();
    if (threadIdx.x == 0) {
        unsigned* bar = b.bar;
        __builtin_amdgcn_s_waitcnt(0);
        unsigned nloc = b.st[0], nx = b.st[1];
        if (nloc == 0u) { xcd_barrier_complete(bar, b.x, nloc, nx); b.st[0] = nloc; b.st[1] = nx; }
        const unsigned old = xb_add(&bar[XB_XSUB(b.x)], 1u);
        const unsigned gen = old / nloc;
        if (old + 1u == (gen + 1u) * nloc) {
            __builtin_amdgcn_fence(__ATOMIC_RELEASE, "agent");
            asm volatile("s_waitcnt vmcnt(0)" ::: "memory");
            const unsigned og = xb_add(&bar[XB_TOP], 1u);
            const unsigned tg = og / nx;
            if (og + 1u == (tg + 1u) * nx) xb_add(&bar[XB_TOPGEN], 1u);
            else XB_SPIN(xb_ld(&bar[XB_TOPGEN]) == tg, bar);
            __builtin_amdgcn_fence(__ATOMIC_ACQUIRE, "agent");
            xb_add(&bar[XB_XGEN(b.x)], 1u);
            asm volatile("s_waitcnt vmcnt(0)" ::: "memory");
        } else {
            XB_SPIN(xb_ld(&bar[XB_XGEN(b.x)]) == gen, bar);
            __builtin_amdgcn_fence(__ATOMIC_ACQUIRE, "agent");
            asm volatile("s_waitcnt vmcnt(0)" ::: "memory");
        }
    }
    __syncthreads();
}

struct Args { const float* in[26]; float* out; unsigned char* ws; int ph_lo, ph_hi, chk, pad; };
struct Frame {
    LAS unsigned char* lds; unsigned char* ws; int tid, lane, wave, G, gw, NGW;
};
#define LDS_WAIT() asm volatile("s_waitcnt lgkmcnt(0)" ::: "memory")
__device__ __forceinline__ float wave_sum(float v) {
#pragma unroll
    for (int o = 1; o < 64; o <<= 1) v += __shfl_xor(v, o);
    return v;
}
__device__ __forceinline__ float gelu_tanh(float x) {
    const float z = 0.7978845608028654f * (x + 0.044715f * x * x * x);
    const float e = __builtin_amdgcn_exp2f(2.0f * LOG2E * z);
    const float th = 1.0f - 2.0f * __builtin_amdgcn_rcpf(e + 1.0f);
    return 0.5f * x * (1.0f + th);
}

__device__ __forceinline__ void p0_transpose_item(const float* W, int N, h16* WT, int ldo, int koff, int row_off, LAS float* scr, int item, int lane) {
    const int nblk = N / 32, kb = item / nblk, nb = item % nblk, k0 = 64 * kb, n0 = 32 * nb;
#pragma unroll 8
    for (int i = 0; i < 32; ++i) { const int kk = 2 * i + (lane >> 5); scr[kk * 33 + (lane & 31)] = W[(size_t)(k0 + kk) * N + n0 + (lane & 31)]; }
    LDS_WAIT(); asm volatile("" ::: "memory");
    const int c = lane & 7;
#pragma unroll
    for (int j = 0; j < 4; ++j) { const int n = (lane >> 3) + 8 * j; const LAS float* s = scr + (8 * c) * 33 + n;
        u32x4 o; o.x = pk2(s[0 * 33], s[1 * 33]); o.y = pk2(s[2 * 33], s[3 * 33]); o.z = pk2(s[4 * 33], s[5 * 33]); o.w = pk2(s[6 * 33], s[7 * 33]);
        *(u32x4*)(WT + (size_t)(row_off + n0 + n) * ldo + koff + k0 + 8 * c) = o; }
    LDS_WAIT(); asm volatile("" ::: "memory");
}
__device__ __forceinline__ void rms_row_to_h16(const float* xrow, const float* gain, h16* orow, int lane) {
    const f32x4* xr = (const f32x4*)xrow + lane; const f32x4* gr = (const f32x4*)gain + lane;
    f32x4 v[8]; float s = 0.f;
#pragma unroll
    for (int j = 0; j < 8; ++j) { v[j] = xr[64 * j]; s += (v[j].x * v[j].x + v[j].y * v[j].y) + (v[j].z * v[j].z + v[j].w * v[j].w); }
    const float r = 1.0f / sqrtf(wave_sum(s) * (1.0f / D) + EPS);
    u32x2* o8 = (u32x2*)orow + lane;
#pragma unroll
    for (int j = 0; j < 8; ++j) { const f32x4 g = gr[64 * j]; u32x2 w; w.x = pk2(v[j].x * r * g.x, v[j].y * r * g.y); w.y = pk2(v[j].z * r * g.z, v[j].w * r * g.w); o8[64 * j] = w; }
}

template <bool FULL>
__device__ __forceinline__ void ssm_wave(const Frame& F, const float* const* in, LAS unsigned char* wl) {
    unsigned char* ws = F.ws; const int lane = F.lane, lq = lane >> 4, lr = lane & 15;
    const int g = F.gw & 63, jw = F.gw >> 6, nj = F.NGW >> 6;
    const f32x4 ab = ((const f32x4*)(ws + WS_AB))[g * 64 + lane];
    const float ar = ab.x, ai = ab.y;
    const h16* PROJ = (const h16*)(ws + WS_PROJ);
    h16x8 bfrag[8];
    const h16x8 zero8 = {0, 0, 0, 0, 0, 0, 0, 0};
#pragma unroll
    for (int mt = 0; mt < 8; ++mt) bfrag[mt] = lq < 2 ? *(const h16x8*)((const h16*)(ws + WS_BB) + ((size_t)(g * 128 + 16 * mt + lr)) * 16 + 8 * lq) : zero8;
    h16x8 cfrag[4]; f32x4 d4 = {0.f, 0.f, 0.f, 0.f};
    if (FULL) {
#pragma unroll
        for (int s = 0; s < 4; ++s) cfrag[s] = *(const h16x8*)((const h16*)(ws + WS_CT) + ((size_t)(g * 16 + lr)) * 128 + 32 * s + 8 * lq);
        d4 = *(const f32x4*)(in[11] + 16 * g + 4 * lq);
    }
    const f32x2* Sg = (const f32x2*)(ws + WS_S) + (size_t)g * 64 + lane;
    for (int j = jw; j < 128; j += nj) {
        const int c = FULL ? (((j >> 5) & 1) ? ((j & ~31) + 31 - (j & 31)) : j) : j;
        const int t0 = 64 * c;
        h16x8 uf[4]; u32x2 uw[4];
#pragma unroll
        for (int sub = 0; sub < 4; ++sub) {
            uf[sub] = lq < 2 ? *(const h16x8*)(PROJ + (size_t)(t0 + 16 * sub + lr) * INC + COL_U + 16 * g + 8 * lq) : zero8;
            if (FULL) uw[sub] = *(const u32x2*)(PROJ + (size_t)(t0 + 16 * sub + lr) * INC + COL_U + 16 * g + 4 * lq);
        }
        float xr = 0.f, xi = 0.f;
        if (FULL) {
            const float alr = ab.z, ali = ab.w;
#pragma unroll 8
            for (int cc = 0; cc < c; ++cc) { const f32x2 sv = Sg[(size_t)cc * 4096]; const float nr = alr * xr - ali * xi + sv.x, ni = alr * xi + ali * xr + sv.y; xr = nr; xi = ni; }
        }
#pragma unroll
        for (int sub = 0; sub < 4; ++sub) {
            const int ts = t0 + 16 * sub;
#pragma unroll
            for (int mt = 0; mt < 8; ++mt) {
                f32x4 a = {0.f, 0.f, 0.f, 0.f};
                a = __builtin_amdgcn_mfma_f32_16x16x32_f16(bfrag[mt], uf[sub], a, 0, 0, 0);
                *(LAS f32x4*)(wl + lr * 528 + (16 * mt + 4 * lq) * 4) = a;
            }
            f32x2 bu[16];
#pragma unroll
            for (int t = 0; t < 16; ++t) bu[t] = *(const LAS f32x2*)(wl + t * 528 + 8 * lane);
#pragma unroll
            for (int t = 0; t < 16; ++t) {
                const float nr = ar * xr - ai * xi + bu[t].x, ni = ar * xi + ai * xr + bu[t].y; xr = nr; xi = ni;
                if (FULL) *(LAS unsigned*)(wl + t * 528 + 4 * lane) = pk2(xr, xi);
            }
            if (FULL) {
                f32x4 y = {0.f, 0.f, 0.f, 0.f};
#pragma unroll
                for (int s = 0; s < 4; ++s) { const h16x8 xf = *(const LAS h16x8*)(wl + lr * 528 + (32 * s + 8 * lq) * 2); y = __builtin_amdgcn_mfma_f32_16x16x32_f16(cfrag[s], xf, y, 0, 0, 0); }
                const f32x4 u4 = pg8::h4_to_f4(uw[sub]);
                f32x4 o;
#pragma unroll
                for (int e = 0; e < 4; ++e) o[e] = gelu_tanh(y[e] + d4[e] * u4[e]);
                u32x2 w; w.x = pk2(o[0], o[1]); w.y = pk2(o[2], o[3]);
                *(u32x2*)((h16*)(ws + WS_YG) + (size_t)(ts + lr) * SSMW + 16 * g + 4 * lq) = w;
            }
        }
        if (!FULL) ((f32x2*)(ws + WS_S))[(size_t)c * 4096 + g * 64 + lane] = (f32x2){xr, xi};
    }
}

__device__ __forceinline__ s16x4 tr_read(const LAS unsigned char* p) {
    typedef short v4i16_t __attribute__((ext_vector_type(4)));
    return __builtin_amdgcn_ds_read_tr16_b64_v4i16((LAS v4i16_t*)p);
}
__device__ __forceinline__ void attn_pair(const Frame& F, int item0) {
    unsigned char* ws = F.ws; const int tid = F.tid, lane = F.lane, wave = F.wave;
    const int half = wave >> 2, qt = wave & 3, r = lane & 31, hh = lane >> 5;
    const int item = item0 + half;
    const int g = item >> 9, hs = (item >> 6) & 7, blk = item & 63;
    const int dl = (g == 0) ? 0 : (g == 1 ? 2 : 4), dil = 1 << dl, res = blk & (dil - 1), n = blk >> dl;
    const h16* PROJ = (const h16*)(ws + WS_PROJ);
    const int hcol = (g * 8 + hs) * 64;
    LAS unsigned char* vimg = F.lds + half * 32768;
    const int t2 = tid & 255, c8 = t2 & 7;
    u32x4 vst[8];
#pragma unroll
    for (int j = 0; j < 8; ++j) {
        const int kj = (t2 >> 3) + 32 * j, idx = (n - 1) * 128 + kj;
        vst[j] = (u32x4){0u, 0u, 0u, 0u};
        if (idx >= 0) vst[j] = *(const u32x4*)(PROJ + (size_t)(idx * dil + res) * INC + COL_V + hcol + 8 * c8);
    }
    const int qpos = ((n * 128 + 32 * qt + r) << dl) + res;
    h16x8 qf[4];
#pragma unroll
    for (int s = 0; s < 4; ++s) qf[s] = *(const h16x8*)(PROJ + (size_t)qpos * INC + hcol + 16 * s + 8 * hh);
    h16x8 kf[5][4];
#pragma unroll
    for (int k5 = 0; k5 < 5; ++k5) {
        const int kj = 32 * (qt + k5) + r, idx = (n - 1) * 128 + kj, pos = ((idx < 0 ? 0 : idx) << dl) + res;
#pragma unroll
        for (int s = 0; s < 4; ++s) kf[k5][s] = *(const h16x8*)(PROJ + (size_t)pos * INC + COL_K + hcol + 16 * s + 8 * hh);
    }
    __builtin_amdgcn_sched_barrier(0);
#pragma unroll
    for (int j = 0; j < 8; ++j) *(LAS u32x4*)(vimg + ((t2 >> 3) + 32 * j) * 128 + c8 * 16) = vst[j];
    const float c1 = 0.125f * LOG2E, c2 = __builtin_amdgcn_exp2f(-(float)(hs + 1)) * (float)dil * LOG2E;
    float mx = -INFINITY;
    f32x16 sc[5];
#pragma unroll
    for (int k5 = 0; k5 < 5; ++k5) {
        f32x16 a = {0.f, 0.f, 0.f, 0.f, 0.f, 0.f, 0.f, 0.f, 0.f, 0.f, 0.f, 0.f, 0.f, 0.f, 0.f, 0.f};
#pragma unroll
        for (int s = 0; s < 4; ++s) a = __builtin_amdgcn_mfma_f32_32x32x16_f16(kf[k5][s], qf[s], a, 0, 0, 0);
        const int sbase = 128 + r - 32 * k5 - 4 * hh;
        const bool tile_ok = (n > 0) || (qt + k5 >= 4);
        const float fb = -c2 * (float)sbase;
#pragma unroll
        for (int i = 0; i < 16; ++i) {
            const int ci = (i & 3) + 8 * (i >> 2);
            const bool ok = tile_ok && ((unsigned)(sbase - ci) <= 128u);
            const float v = ok ? __builtin_fmaf(a[i], c1, fb + c2 * (float)ci) : -INFINITY;
            a[i] = v; mx = fmaxf(mx, v);
        }
        sc[k5] = a;
    }
    mx = fmaxf(mx, __shfl_xor(mx, 32));
    float l = 0.f;
#pragma unroll
    for (int k5 = 0; k5 < 5; ++k5)
#pragma unroll
        for (int i = 0; i < 16; ++i) { const float p = __builtin_amdgcn_exp2f(sc[k5][i] - mx); sc[k5][i] = p; l += p; }
    l += __shfl_xor(l, 32);
    __syncthreads();
    f32x16 o0 = {0.f, 0.f, 0.f, 0.f, 0.f, 0.f, 0.f, 0.f, 0.f, 0.f, 0.f, 0.f, 0.f, 0.f, 0.f, 0.f}, o1 = o0;
    const int vq = (lane & 15) >> 2, vp = lane & 3, vg = (lane >> 4) & 1;
    const LAS unsigned char* vb = vimg + (4 * hh + vq) * 128 + (16 * vg + 4 * vp) * 2;
#pragma unroll
    for (int k5 = 0; k5 < 5; ++k5)
#pragma unroll
        for (int s = 0; s < 2; ++s) {
            u32x4 pw; pw.x = pk2(sc[k5][8 * s + 0], sc[k5][8 * s + 1]); pw.y = pk2(sc[k5][8 * s + 2], sc[k5][8 * s + 3]); pw.z = pk2(sc[k5][8 * s + 4], sc[k5][8 * s + 5]); pw.w = pk2(sc[k5][8 * s + 6], sc[k5][8 * s + 7]);
            const h16x8 pf = __builtin_bit_cast(h16x8, pw);
            const LAS unsigned char* vr = vb + (32 * (qt + k5) + 16 * s) * 128;
            const s16x4 a0 = tr_read(vr), a1 = tr_read(vr + 8 * 128), b0 = tr_read(vr + 64), b1 = tr_read(vr + 8 * 128 + 64);
            typedef short s16x8 __attribute__((ext_vector_type(8)));
            const s16x8 va = {a0[0], a0[1], a0[2], a0[3], a1[0], a1[1], a1[2], a1[3]}, vbb = {b0[0], b0[1], b0[2], b0[3], b1[0], b1[1], b1[2], b1[3]};
            o0 = __builtin_amdgcn_mfma_f32_32x32x16_f16(__builtin_bit_cast(h16x8, va), pf, o0, 0, 0, 0);
            o1 = __builtin_amdgcn_mfma_f32_32x32x16_f16(__builtin_bit_cast(h16x8, vbb), pf, o1, 0, 0, 0);
        }
    const float il = 1.0f / l;
    h16* og = (h16*)(ws + WS_OG) + ((size_t)g * T + qpos) * 512 + hs * 64;
#pragma unroll
    for (int q4 = 0; q4 < 4; ++q4) {
        u32x2 w; w.x = pk2(o0[4 * q4] * il, o0[4 * q4 + 1] * il); w.y = pk2(o0[4 * q4 + 2] * il, o0[4 * q4 + 3] * il);
        *(u32x2*)(og + 8 * q4 + 4 * hh) = w;
        w.x = pk2(o1[4 * q4] * il, o1[4 * q4 + 1] * il); w.y = pk2(o1[4 * q4 + 2] * il, o1[4 * q4 + 3] * il);
        *(u32x2*)(og + 32 + 8 * q4 + 4 * hh) = w;
    }
    if (hh == 0) ((float*)(ws + WS_LSE))[((size_t)g * T + qpos) * 8 + hs] = mx * LN2 + __logf(l);
    __syncthreads();
}


#ifndef DBGCHK
#define DBGCHK 0
#endif
constexpr int CW_DBG = 8256;
__device__ __forceinline__ unsigned hsh(unsigned x) { x ^= x >> 16; x *= 0x7feb352du; x ^= x >> 15; x *= 0x846ca68bu; x ^= x >> 16; return x; }
__device__ __forceinline__ void chk_fail(unsigned* ctl, int code) { atomicMax(ctl + CW_DBG, (unsigned)(100 - code)); }
__device__ __forceinline__ bool close_(float a, float b) { return fabsf(a - b) <= 0.01f * fabsf(b) + 0.01f && a == a; }
__device__ __forceinline__ float dot_hh(const h16* a, const h16* b, int K) { float s = 0.f; for (int k = 0; k < K; ++k) s += (float)a[k] * (float)b[k]; return s; }
__device__ __forceinline__ void run_checks(int after, const float* const* in, unsigned char* ws, unsigned* ctl, int tid) {
    const unsigned r0 = hsh(tid * 7919u + after * 104729u + 12345u), r1 = hsh(r0 + 1u), r2 = hsh(r1 + 7u);
    const h16* PROJ = (const h16*)(ws + WS_PROJ);
    if (after == 0) {
        {
            const int row = r0 % T, col = r1 % D; const float* xr = in[0] + (size_t)row * D; float ss = 0.f;
            for (int k = 0; k < D; ++k) ss += xr[k] * xr[k];
            const float v = xr[col] / sqrtf(ss / D + EPS) * in[1][col];
            if (!close_((float)((const h16*)(ws + WS_H))[(size_t)row * D + col], v)) chk_fail(ctl, 1);
        }
        {
            int n = r1 % INC, k = r2 % D;
            if (!close_((float)((const h16*)(ws + WS_WIN))[(size_t)n * D + k], in[2][(size_t)k * INC + n])) chk_fail(ctl, 2);
            n = r1 % 1024; k = r2 % 1024;
            if (!close_((float)((const h16*)(ws + WS_WGLU))[(size_t)n * 1024 + k], in[12][(size_t)k * 1024 + n])) chk_fail(ctl, 2);
            n = r1 % D; k = r2 % 512;
            if (!close_((float)((const h16*)(ws + WS_WUP))[(size_t)n * 1536 + k], in[14][(size_t)k * D + n])) chk_fail(ctl, 2);
            k = r2 % 1024;
            if (!close_((float)((const h16*)(ws + WS_WUP))[(size_t)n * 1536 + 512 + k], in[15][(size_t)k * D + n])) chk_fail(ctl, 2);
            k = r2 % D;
            if (!close_((float)((const h16*)(ws + WS_WOUT))[(size_t)n * D + k], in[16][(size_t)k * D + n])) chk_fail(ctl, 2);
            const int e = r0 % NE; n = r1 % FF; k = r2 % D;
            if (!close_((float)((const h16*)(ws + WS_WGU))[((size_t)e * 1024 + n) * D + k], in[22][((size_t)e * D + k) * FF + n])) chk_fail(ctl, 2);
            if (!close_((float)((const h16*)(ws + WS_WGU))[((size_t)e * 1024 + 512 + n) * D + k], in[23][((size_t)e * D + k) * FF + n])) chk_fail(ctl, 2);
            n = r1 % D; k = r2 % FF;
            if (!close_((float)((const h16*)(ws + WS_WDN))[((size_t)e * D + n) * FF + k], in[24][((size_t)e * FF + k) * D + n])) chk_fail(ctl, 2);
        }
    }
    if (after == 1) {
        const int row = r0 % T; int col = r1 % INC; if (tid & 1) col = COL_G + (r1 % 4096);
        float v = dot_hh((const h16*)(ws + WS_H) + (size_t)row * D, (const h16*)(ws + WS_WIN) + (size_t)col * D, D);
        if (col >= COL_G) v = 1.f / (1.f + expf(-(v + in[3][col - COL_G])));
        if (!close_((float)PROJ[(size_t)row * INC + col], v)) chk_fail(ctl, 3);
    }
    if (after == 2) {
        const int g = r0 % 3, t = r1 % T, hs = r2 % 8, dil = (g == 0) ? 1 : (g == 1 ? 4 : 16), hcol = (g * 8 + hs) * 64;
        const float slope = exp2f(-(float)(hs + 1));
        const h16* q = PROJ + (size_t)t * INC + hcol;
        float mx = -INFINITY;
        for (int j = 0; j <= 128; ++j) { const int tk = t - j * dil; if (tk < 0) break; const float sc = dot_hh(q, PROJ + (size_t)tk * INC + COL_K + hcol, 64) * 0.125f - slope * (float)(dil * j); mx = fmaxf(mx, sc); }
        float l = 0.f, o0 = 0.f, o1 = 0.f; const int d0 = r2 % 64, d1 = (r2 >> 8) % 64;
        for (int j = 0; j <= 128; ++j) { const int tk = t - j * dil; if (tk < 0) break; const float sc = dot_hh(q, PROJ + (size_t)tk * INC + COL_K + hcol, 64) * 0.125f - slope * (float)(dil * j);
            const float p = expf(sc - mx); l += p; o0 += p * (float)PROJ[(size_t)tk * INC + COL_V + hcol + d0]; o1 += p * (float)PROJ[(size_t)tk * INC + COL_V + hcol + d1]; }
        const h16* og = (const h16*)(ws + WS_OG) + ((size_t)g * T + t) * 512 + hs * 64;
        if (!close_((float)og[d0], o0 / l) || !close_((float)og[d1], o1 / l)) chk_fail(ctl, 4);
        if (!close_(((const float*)(ws + WS_LSE))[((size_t)g * T + t) * 8 + hs], mx + logf(l))) chk_fail(ctl, 5);
    }
    if (after == 3) {
        {
            const int t = r0 % T, hs = r1 % 8, d = r2 % 64; const float* LSE = (const float*)(ws + WS_LSE);
            float lse[3], m = -INFINITY; for (int g = 0; g < 3; ++g) { lse[g] = LSE[((size_t)g * T + t) * 8 + hs]; m = fmaxf(m, lse[g]); }
            float den = 0.f, num = 0.f; for (int g = 0; g < 3; ++g) { const float w = expf(lse[g] - m); den += w; num += w * (float)((const h16*)(ws + WS_OG))[((size_t)g * T + t) * 512 + hs * 64 + d]; }
            const h16 av = ((const h16*)(ws + WS_ACAT))[(size_t)t * 1536 + hs * 64 + d]; const float bv = num / den;
            if (__builtin_bit_cast(unsigned short, av) == 0xAAAAu) chk_fail(ctl, 6);
            else if (!(fabsf(bv) < 1e30f)) chk_fail(ctl, 7);
            else if (!close_((float)av, bv)) { chk_fail(ctl, 8); atomicAdd(ctl + CW_DBG + 1, 1u); if (t < 2048) atomicAdd(ctl + CW_DBG + 2, 1u); }
        }
        {
            const int wv = tid >> 6, p = tid & 63, gq = (wv * 9 + 3) % 64, gp = gq * 64 + p;
            const float are = in[4][gp], aim = in[5][gp], step = expf(in[6][gq]), mag = expf(are * step), ang = aim * step;
            const float br = mag * cosf(ang), bi = mag * sinf(ang), nr = br - 1.f, ni = bi, den = are * are + aim * aim;
            const float fr_ = (nr * are + ni * aim) / den, fi_ = (ni * are - nr * aim) / den;
            float bbr[16], bbi[16];
#pragma unroll
            for (int h = 0; h < 16; ++h) { const float b_r = in[7][(size_t)gp * 16 + h], b_i = in[8][(size_t)gp * 16 + h]; bbr[h] = fr_ * b_r - fi_ * b_i; bbi[h] = fr_ * b_i + fi_ * b_r; }
            float xr = 0.f, xi = 0.f; int ci = 0, tn = 5;
            for (int t = 0; t < T; ++t) {
                float bur = 0.f, bui = 0.f;
#pragma unroll
                for (int h = 0; h < 16; ++h) { const float u = (float)PROJ[(size_t)t * INC + COL_U + gq * 16 + h]; bur += bbr[h] * u; bui += bbi[h] * u; }
                const float nr2 = br * xr - bi * xi + bur, ni2 = br * xi + bi * xr + bui; xr = nr2; xi = ni2;
                if (t == tn) {
                    for (int h = 0; h < 16; ++h) {
                        float yv = in[9][((size_t)gq * 16 + h) * 64 + p] * xr - in[10][((size_t)gq * 16 + h) * 64 + p] * xi;
                        yv = wave_sum(yv);
                        yv += in[11][gq * 16 + h] * (float)PROJ[(size_t)t * INC + COL_U + gq * 16 + h];
                        const float z = 0.7978845608028654f * (yv + 0.044715f * yv * yv * yv), ge = 0.5f * yv * (1.f + tanhf(z));
                        if (p == 0 && !close_((float)((const h16*)(ws + WS_YG))[(size_t)t * SSMW + gq * 16 + h], ge)) chk_fail(ctl, 9);
                    }
                    ++ci; tn = (ci == 1) ? 64 + wv : (ci == 2 ? 1000 + 17 * wv : T - 1);
                }
            }
        }
    }
    if (after == 4) {
        const int row = r0 % T, c = r1 % 1024; const h16* yg = (const h16*)(ws + WS_YG) + (size_t)row * SSMW;
        const float v = dot_hh(yg, (const h16*)(ws + WS_WGLU) + (size_t)c * 1024, 1024) + in[13][c];
        if (!close_((float)((const h16*)(ws + WS_ACAT))[(size_t)row * 1536 + 512 + c], (float)yg[c] / (1.f + expf(-v)))) chk_fail(ctl, 10);
    }
    if (after == 5) {
        const int row = r0 % T, c = r1 % D; const h16* a = (const h16*)(ws + WS_ACAT) + (size_t)row * 1536; const h16* w = (const h16*)(ws + WS_WUP) + (size_t)c * 1536;
        const float va = dot_hh(a, w, 512), vs = dot_hh(a + 512, w + 512, 1024);
        const float ga = (float)PROJ[(size_t)row * INC + COL_G + c], gs = (float)PROJ[(size_t)row * INC + COL_G + D + c];
        if (!close_((float)((const h16*)(ws + WS_MERGED))[(size_t)row * D + c], ga * va + gs * vs)) chk_fail(ctl, 11);
    }
    if (after == 6) {
        const int row = r0 % T, c = r1 % D;
        const float v = in[0][(size_t)row * D + c] + dot_hh((const h16*)(ws + WS_MERGED) + (size_t)row * D, (const h16*)(ws + WS_WOUT) + (size_t)c * D, D);
        if (!close_(((const float*)(ws + WS_X1))[(size_t)row * D + c], v)) chk_fail(ctl, 12);
    }
}

__global__ void __launch_bounds__(NWAVES * 64, 2) fwd_kernel(Args args) {
    extern __shared__ __attribute__((aligned(16))) unsigned char lds_raw[];
    Frame F;
    F.lds = (LAS unsigned char*)lds_raw; F.ws = args.ws;
    F.tid = threadIdx.x; F.lane = F.tid & 63; F.wave = __builtin_amdgcn_readfirstlane(F.tid >> 6);
    F.G = gridDim.x; F.gw = blockIdx.x * NWAVES + F.wave; F.NGW = F.G * NWAVES;
    unsigned char* ws = args.ws;
    const float* const* in = args.in;
    volatile LAS unsigned* MISC = (volatile LAS unsigned*)(F.lds + MISC_OFF);
    for (int u = F.tid; u < (LDS_BYTES - LDSCTL_OFF) / 4; u += NWAVES * 64) ((LAS unsigned*)(F.lds + LDSCTL_OFF))[u] = 0u;
    __syncthreads();
    unsigned* ctl = (unsigned*)(ws + WS_CTL);
    XcdBarrier bar; bar.bar = ctl + CW_BAR; bar.x = 0; bar.st = nullptr;
    if (MK_N_LAUNCHES == 1) bar = xcd_barrier_post(ctl + CW_BAR, MISC + 8);
    const int lo = args.ph_lo, hi = args.ph_hi;
#ifndef PH_MASK
#define PH_MASK 0xFFF
#endif
#define IN(k) ((((PH_MASK) >> (k)) & 1) && lo <= (k) && (k) < hi)
#ifndef DUP_MASK
#define DUP_MASK 0
#endif
#define REPS(k) (1 + (((DUP_MASK) >> (k)) & 1))
#ifndef XBAR
#define XBAR 1
#endif
#define SEAM(k) do { if (IN(k) && IN((k) + 1)) for (int b_ = 0; b_ < XBAR; ++b_) xcd_barrier(bar); } while (0)
    const int lane = F.lane, wave = F.wave, tid = F.tid;
    if (DBGCHK && args.chk > 0) { if (blockIdx.x == 0) run_checks(args.chk - 1, in, ws, ctl, tid); return; }

    if (IN(0)) for (int rep_ = 0; rep_ < REPS(0); ++rep_) {
        LAS float* scr = (LAS float*)(F.lds + wave * 16384);
        const int gw = F.gw, NGW = F.NGW;
        constexpr int I_IN = (D / 64) * (INC / 32), I_GLU = (1024 / 64) * (1024 / 32), I_UA = (512 / 64) * (D / 32), I_US = (1024 / 64) * (D / 32), I_OUT = (D / 64) * (D / 32);
        constexpr int I_EG = (D / 64) * (FF / 32), I_ED = (FF / 64) * (D / 32);
        constexpr int NIT = I_IN + I_GLU + I_UA + I_US + I_OUT + NE * (2 * I_EG + I_ED);
        for (int it = gw; it < NIT; it += NGW) {
            int rr = it;
            if (rr < I_IN) { p0_transpose_item(in[2], INC, (h16*)(ws + WS_WIN), D, 0, 0, scr, rr, lane); continue; } rr -= I_IN;
            if (rr < I_GLU) { p0_transpose_item(in[12], 1024, (h16*)(ws + WS_WGLU), 1024, 0, 0, scr, rr, lane); continue; } rr -= I_GLU;
            if (rr < I_UA) { p0_transpose_item(in[14], D, (h16*)(ws + WS_WUP), 1536, 0, 0, scr, rr, lane); continue; } rr -= I_UA;
            if (rr < I_US) { p0_transpose_item(in[15], D, (h16*)(ws + WS_WUP), 1536, 512, 0, scr, rr, lane); continue; } rr -= I_US;
            if (rr < I_OUT) { p0_transpose_item(in[16], D, (h16*)(ws + WS_WOUT), D, 0, 0, scr, rr, lane); continue; } rr -= I_OUT;
            const int per_e = 2 * I_EG + I_ED, e = rr / per_e; rr -= e * per_e;
            if (rr < I_EG) { p0_transpose_item(in[22] + (size_t)e * D * FF, FF, (h16*)(ws + WS_WGU) + (size_t)e * 1024 * D, D, 0, 0, scr, rr, lane); continue; } rr -= I_EG;
            if (rr < I_EG) { p0_transpose_item(in[23] + (size_t)e * D * FF, FF, (h16*)(ws + WS_WGU) + (size_t)e * 1024 * D, D, 0, 512, scr, rr, lane); continue; } rr -= I_EG;
            p0_transpose_item(in[24] + (size_t)e * FF * D, D, (h16*)(ws + WS_WDN) + (size_t)e * D * FF, FF, 0, 0, scr, rr, lane);
        }
        for (int m = gw; m < T; m += NGW) rms_row_to_h16(in[0] + (size_t)m * D, in[1], (h16*)(ws + WS_H) + (size_t)m * D, lane);
        {
            const int gt = blockIdx.x * (NWAVES * 64) + tid;
            if (gt < 4096) {
                const int g = gt >> 6, p = gt & 63;
                const float are = in[4][gt], aim = in[5][gt], step = expf(in[6][g]);
                const float mag = expf(are * step), ang = aim * step;
                float sn, cs; sincosf(ang, &sn, &cs);
                const float br = mag * cs, bi = mag * sn;
                float pr = br, pi = bi;
#pragma unroll
                for (int k = 0; k < 6; ++k) { const float nr2 = pr * pr - pi * pi, ni2 = 2.f * pr * pi; pr = nr2; pi = ni2; }
                ((f32x4*)(ws + WS_AB))[gt] = (f32x4){br, bi, pr, pi};
                const float nr = br - 1.0f, ni = bi, den = are * are + aim * aim;
                const float fr_ = (nr * are + ni * aim) / den, fi_ = (ni * are - nr * aim) / den;
                h16* BB = (h16*)(ws + WS_BB) + ((size_t)g * 128 + 2 * p) * 16;
                const float* bre = in[7] + (size_t)gt * 16; const float* bim = in[8] + (size_t)gt * 16;
#pragma unroll
                for (int h = 0; h < 16; ++h) { BB[h] = (h16)(fr_ * bre[h] - fi_ * bim[h]); BB[16 + h] = (h16)(fr_ * bim[h] + fi_ * bre[h]); }
                h16* CT = (h16*)(ws + WS_CT) + (size_t)g * 16 * 128 + 2 * p;
#pragma unroll
                for (int h = 0; h < 16; ++h) { CT[h * 128] = (h16)in[9][((size_t)g * 16 + h) * 64 + p]; CT[h * 128 + 1] = (h16)(-in[10][((size_t)g * 16 + h) * 64 + p]); }
            }
        }
        for (int i = blockIdx.x * (NWAVES * 64) + tid; i < D * 64; i += F.G * NWAVES * 64) {
            const int k = i >> 6, j = i & 63; const float gn = in[17][k];
            float v = 0.f; if (j < 32) v = in[20][k * 32 + j] * gn; else if (j < 36) v = in[18][k * 4 + (j - 32)] * gn;
            ((float*)(ws + WS_WR))[(((k >> 2) * 64 + j) << 2) + (k & 3)] = v;
        }
    }
    SEAM(0);

    if (IN(1)) for (int rep_ = 0; rep_ < REPS(1); ++rep_) {
        pg8::Gemm g{(const h16*)(ws + WS_H), (const h16*)(ws + WS_WIN), D, (size_t)pg8::HALF * D * 2};
        pg8::StaticOrder S; S.init(T, INC, D, F.G, (int)blockIdx.x);
        pg8::EpiProj E{(h16*)(ws + WS_PROJ), in[3]};
        pg8::gemm_phase<pg8::EpiProj, pg8::StaticOrder>(F.lds, g, S, E);
    }
    SEAM(1);

    if (IN(2)) for (int rep_ = 0; rep_ < REPS(2); ++rep_) {
#ifndef NO_ATTN
        for (int it = blockIdx.x; it < 768; it += F.G) attn_pair(F, 2 * it);
#endif
#ifndef NO_SSM1
        ssm_wave<false>(F, in, F.lds + wave * 16384);
#endif
    }
    SEAM(2);

    if (IN(3)) for (int rep_ = 0; rep_ < REPS(3); ++rep_) {
        for (int i = blockIdx.x * (NWAVES * 64) + tid; i < T * 64; i += F.G * NWAVES * 64) {
            const int t = i >> 6, hsl = (i >> 3) & 7, c8 = i & 7;
            const float* LSE = (const float*)(ws + WS_LSE);
            const float l0 = LSE[((size_t)0 * T + t) * 8 + hsl], l1 = LSE[((size_t)1 * T + t) * 8 + hsl], l2 = LSE[((size_t)2 * T + t) * 8 + hsl];
            const float m = fmaxf(l0, fmaxf(l1, l2));
            float w0 = __expf(l0 - m), w1 = __expf(l1 - m), w2 = __expf(l2 - m); const float inv = 1.0f / (w0 + w1 + w2); w0 *= inv; w1 *= inv; w2 *= inv;
            const h16* OG = (const h16*)(ws + WS_OG) + (size_t)t * 512 + hsl * 64 + c8 * 8;
            const u32x4 a = *(const u32x4*)OG, b = *(const u32x4*)(OG + (size_t)T * 512), cc = *(const u32x4*)(OG + (size_t)2 * T * 512);
            u32x4 o;
#pragma unroll
            for (int e = 0; e < 4; ++e) {
                const h16x2 ha = pg8::as_h2(a[e]), hb = pg8::as_h2(b[e]), hc = pg8::as_h2(cc[e]);
                o[e] = pk2(w0 * (float)ha.x + w1 * (float)hb.x + w2 * (float)hc.x, w0 * (float)ha.y + w1 * (float)hb.y + w2 * (float)hc.y);
            }
            if (DBG & 1) o = (u32x4){0u, 0u, 0u, 0u};
            *(u32x4*)((h16*)(ws + WS_ACAT) + (size_t)t * 1536 + hsl * 64 + c8 * 8) = o;
        }
        ssm_wave<true>(F, in, F.lds + wave * 16384);
    }
    SEAM(3);

    if (IN(4)) for (int rep_ = 0; rep_ < REPS(4); ++rep_) {
        pg8::Gemm g{(const h16*)(ws + WS_YG), (const h16*)(ws + WS_WGLU), 1024, (size_t)pg8::HALF * 1024 * 2};
        pg8::StaticOrder S; S.init(T, 1024, 1024, F.G, (int)blockIdx.x);
        pg8::EpiGlu E{(const h16*)(ws + WS_YG), (h16*)(ws + WS_ACAT), in[13]};
        pg8::gemm_phase<pg8::EpiGlu, pg8::StaticOrder>(F.lds, g, S, E);
    }
    SEAM(4);

    if (IN(5)) for (int rep_ = 0; rep_ < REPS(5); ++rep_) {
        pg8::Gemm g{(const h16*)(ws + WS_ACAT), (const h16*)(ws + WS_WUP), 1536, (size_t)pg8::HALF * 1536 * 2};
        pg8::StaticOrder S; S.init(T, D, 1536, F.G, (int)blockIdx.x);
        pg8::EpiUp E{(const h16*)(ws + WS_PROJ), (h16*)(ws + WS_MERGED)};
        pg8::gemm_phase<pg8::EpiUp, pg8::StaticOrder>(F.lds, g, S, E);
    }
    SEAM(5);

    if (IN(6)) for (int rep_ = 0; rep_ < REPS(6); ++rep_) {
        pg8::Gemm g{(const h16*)(ws + WS_MERGED), (const h16*)(ws + WS_WOUT), D, (size_t)pg8::HALF * D * 2};
        pg8::StaticOrder S; S.init(T, D, D, F.G, (int)blockIdx.x);
        pg8::EpiOut E{in[0], (float*)(ws + WS_X1)};
        pg8::gemm_phase<pg8::EpiOut, pg8::StaticOrder>(F.lds, g, S, E);
    }
    SEAM(6);

    if (IN(7)) for (int rep_ = 0; rep_ < REPS(7); ++rep_) {
        const float* X1 = (const float*)(ws + WS_X1); const float* WR = (const float*)(ws + WS_WR);
        LAS float* part = (LAS float*)F.lds;
        LAS f32x4* sinfo = (LAS f32x4*)(F.lds + 8 * 32 * 65 * 4);
        for (int tb = blockIdx.x; tb < T / 32; tb += F.G) {
            const int t0 = tb * 32, i = lane & 31, kk = lane >> 5, kbase = wave * 256;
            f32x16 ae = {0.f, 0.f, 0.f, 0.f, 0.f, 0.f, 0.f, 0.f, 0.f, 0.f, 0.f, 0.f, 0.f, 0.f, 0.f, 0.f}, ag = ae;
            float ss = 0.f;
            const float* xrow = X1 + (size_t)(t0 + i) * D + kbase + 4 * kk;
            const f32x4* wq = (const f32x4*)WR + (size_t)(kbase / 4 + kk) * 64 + i;
#pragma unroll 4
            for (int m = 0; m < 32; ++m) {
                const f32x4 xv = *(const f32x4*)(xrow + 8 * m);
                const f32x4 we = wq[(size_t)m * 128], wg = wq[(size_t)m * 128 + 32];
                ss += (xv.x * xv.x + xv.y * xv.y) + (xv.z * xv.z + xv.w * xv.w);
#pragma unroll
                for (int e = 0; e < 4; ++e) {
                    ae = __builtin_amdgcn_mfma_f32_32x32x2f32(xv[e], we[e], ae, 0, 0, 0);
                    ag = __builtin_amdgcn_mfma_f32_32x32x2f32(xv[e], wg[e], ag, 0, 0, 0);
                }
            }
            ss += __shfl_xor(ss, 32);
            LAS float* pw = part + wave * (32 * 65);
#pragma unroll
            for (int q = 0; q < 16; ++q) { const int tr = (q & 3) + 8 * (q >> 2) + 4 * kk; pw[tr * 65 + i] = ae[q]; if (i < 4) pw[tr * 65 + 32 + i] = ag[q]; }
            if (kk == 0) pw[i * 65 + 64] = ss;
            __syncthreads();
            if (tid < 32) {
                const int t = t0 + tid; float lg[36]; float sq = 0.f;
#pragma unroll
                for (int j = 0; j < 36; ++j) lg[j] = 0.f;
                for (int w = 0; w < 8; ++w) { const LAS float* p = part + w * (32 * 65) + tid * 65;
#pragma unroll
                    for (int j = 0; j < 36; ++j) lg[j] += p[j];
                    sq += p[64]; }
                const float rs = 1.0f / sqrtf(sq * (1.0f / D) + EPS);
                float gl[4]; int gi = 0; float gm;
#pragma unroll
                for (int j = 0; j < 4; ++j) gl[j] = lg[32 + j] * rs + in[19][j];
                gm = gl[0];
#pragma unroll
                for (int j = 1; j < 4; ++j) if (gl[j] > gm) { gm = gl[j]; gi = j; }
                float gsum = 0.f;
#pragma unroll
                for (int j = 0; j < 4; ++j) gsum += expf(gl[j] - gm);
                const float gp = 1.0f / gsum;
                float el[8];
#pragma unroll
                for (int j = 0; j < 8; ++j) { float v = 0.f;
#pragma unroll
                    for (int q = 0; q < 4; ++q) v = (gi == q) ? lg[q * 8 + j] : v;
                    el[j] = v * rs + in[21][gi * 8 + j]; }
                int j0 = 0; float v0 = el[0];
#pragma unroll
                for (int j = 1; j < 8; ++j) if (el[j] > v0) { v0 = el[j]; j0 = j; }
                int j1 = -1; float v1 = -INFINITY;
#pragma unroll
                for (int j = 0; j < 8; ++j) if (j != j0 && el[j] > v1) { v1 = el[j]; j1 = j; }
                const float e1 = expf(v1 - v0), w0 = gp / (1.0f + e1), w1 = gp * e1 / (1.0f + e1);
                const int ex0 = gi * 8 + j0, ex1 = gi * 8 + j1;
                const unsigned s0 = atomicAdd(ctl + CW_CNT + ex0, 1u), s1 = atomicAdd(ctl + CW_CNT + ex1, 1u);
                int row0 = ex0 * CAP + (int)s0, row1 = ex1 * CAP + (int)s1;
                if (s0 >= (unsigned)CAP) { const unsigned ix = atomicAdd(ctl + CW_OVF, 1u); ((int4*)(ws + WS_OVF))[ix] = make_int4(t, ex0, 0, 0); row0 = -1; }
                if (s1 >= (unsigned)CAP) { const unsigned ix = atomicAdd(ctl + CW_OVF, 1u); ((int4*)(ws + WS_OVF))[ix] = make_int4(t, ex1, 1, 0); row1 = -1; }
                ((int2*)(ws + WS_TOKROW))[t] = make_int2(row0, row1);
                ((f32x4*)(ws + WS_ROUTF))[t] = (f32x4){w0, w1, rs, 0.f};
                sinfo[tid] = (f32x4){__int_as_float(row0), __int_as_float(row1), rs, 0.f};
            }
            __syncthreads();
#pragma unroll 1
            for (int q = 0; q < 4; ++q) {
                const int tl_ = wave * 4 + q; const f32x4 si = sinfo[tl_]; const int row0 = __float_as_int(si.x), row1 = __float_as_int(si.y); const float rs = si.z;
                const f32x4* xr = (const f32x4*)(X1 + (size_t)(t0 + tl_) * D) + lane; const f32x4* gr = (const f32x4*)in[17] + lane;
                u32x2* o0 = (u32x2*)((h16*)(ws + WS_XS) + (size_t)(row0 < 0 ? 0 : row0) * D) + lane; u32x2* o1 = (u32x2*)((h16*)(ws + WS_XS) + (size_t)(row1 < 0 ? 0 : row1) * D) + lane;
#pragma unroll
                for (int j = 0; j < 8; ++j) { const f32x4 v = xr[64 * j], gn = gr[64 * j]; u32x2 w; w.x = pk2(v.x * rs * gn.x, v.y * rs * gn.y); w.y = pk2(v.z * rs * gn.z, v.w * rs * gn.w);
                    if (row0 >= 0) o0[64 * j] = w; if (row1 >= 0) o1[64 * j] = w; }
            }
            __syncthreads();
        }
    }
    if (IN(7) && IN(9)) xcd_barrier(bar);


    LAS int* tlist = (LAS int*)(F.lds + LDSCTL_OFF + 1024);
    if (IN(9) || IN(10)) {
        if (tid == 0) {
            int nt_ = 0;
            for (int x = 0; x < 8; ++x) { tlist[x] = nt_;
                for (int pass = 0; pass < 2; ++pass)
                    for (int e = x; e < NE; e += 8) { int c = (int)xb_ld(ctl + CW_CNT + e); c = c > CAP ? CAP : c;
                        for (int j = 0; j < CAPT; ++j) { const int rows = c - 256 * j; const bool full = rows > 128, half = rows > 0 && rows <= 128;
                            if (pass == 0 ? full : half) { tlist[16 + nt_] = (e * CAPT + j) | (pass << 16); ++nt_; } } }
                tlist[8 + x] = nt_ - tlist[x]; }
        }
        __syncthreads();
    }
    if (IN(9)) for (int rep_ = 0; rep_ < REPS(9); ++rep_) {
        {
            const int novf = (int)xb_ld(ctl + CW_OVF);
            LAS float* hrow = (LAS float*)F.lds; LAS float* hidv = hrow + D;
            for (int ix = blockIdx.x; ix < novf && rep_ == 0; ix += F.G) {
                const int4 en = ((const int4*)(ws + WS_OVF))[ix]; const f32x4 rf = ((const f32x4*)(ws + WS_ROUTF))[en.x];
                const float* xr = (const float*)(ws + WS_X1) + (size_t)en.x * D;
                for (int k = tid; k < D; k += NWAVES * 64) hrow[k] = (float)(h16)(xr[k] * rf.z * in[17][k]);
                __syncthreads();
                { const h16* wg = (const h16*)(ws + WS_WGU) + ((size_t)en.y * 1024 + tid) * D; const h16* wu = wg + (size_t)512 * D; float ga = 0.f, up = 0.f;
                  for (int k = 0; k < D; ++k) { ga += hrow[k] * (float)wg[k]; up += hrow[k] * (float)wu[k]; }
                  hidv[tid] = (float)(h16)(ga * pg8::sigmoidf_(ga) * up); }
                __syncthreads();
                const float wk = en.z ? rf.y : rf.x;
                for (int c = tid; c < D; c += NWAVES * 64) { const h16* wd = (const h16*)(ws + WS_WDN) + ((size_t)en.y * D + c) * FF; float y = 0.f;
                    for (int k = 0; k < FF; ++k) y += hidv[k] * (float)wd[k];
                    atomicAdd((float*)(ws + WS_X1) + (size_t)en.x * D + c, wk * (float)(h16)y); }
                __syncthreads();
            }
        }
        pg8::Gemm g{(const h16*)(ws + WS_XS), (const h16*)(ws + WS_WGU), D, (size_t)512 * D * 2};
        pg8::ExpertOrder S{tlist, 4, F.G, (int)blockIdx.x, (size_t)1024 * D * 2, (size_t)pg8::HALF * D * 2};
        pg8::EpiGateUp E{(h16*)(ws + WS_HID)};
        pg8::gemm_phase<pg8::EpiGateUp, pg8::ExpertOrder, true, true>(F.lds, g, S, E);
    }
    SEAM(9);

    if (IN(10)) for (int rep_ = 0; rep_ < REPS(10); ++rep_) {
        pg8::Gemm g{(const h16*)(ws + WS_HID), (const h16*)(ws + WS_WDN), FF, (size_t)pg8::HALF * FF * 2};
        pg8::ExpertOrder S{tlist, 8, F.G, (int)blockIdx.x, (size_t)D * FF * 2, (size_t)pg8::BM * FF * 2};
        pg8::EpiDown E{(h16*)(ws + WS_Y)};
        pg8::gemm_phase<pg8::EpiDown, pg8::ExpertOrder, true, true>(F.lds, g, S, E);
    }
    SEAM(10);

    if (IN(11)) for (int rep_ = 0; rep_ < REPS(11); ++rep_) {
        const float* X1 = (const float*)(ws + WS_X1); const h16* Y = (const h16*)(ws + WS_Y);
        for (int t = F.gw; t < T; t += F.NGW) {
            const int2 tr = ((const int2*)(ws + WS_TOKROW))[t]; const f32x4 rf = ((const f32x4*)(ws + WS_ROUTF))[t];
            const f32x4* xr = (const f32x4*)(X1 + (size_t)t * D) + lane;
            const u32x2* y0 = (const u32x2*)(Y + (size_t)(tr.x < 0 ? 0 : tr.x) * D) + lane; const u32x2* y1 = (const u32x2*)(Y + (size_t)(tr.y < 0 ? 0 : tr.y) * D) + lane;
            const float wa = tr.x < 0 ? 0.f : rf.x, wb = tr.y < 0 ? 0.f : rf.y;
            f32x4 v[8]; float s = 0.f;
#pragma unroll
            for (int j = 0; j < 8; ++j) { const f32x4 a = pg8::h4_to_f4(y0[64 * j]), b = pg8::h4_to_f4(y1[64 * j]); v[j] = (DBG & 4) ? xr[64 * j] : xr[64 * j] + wa * a + wb * b;
                s += (v[j].x * v[j].x + v[j].y * v[j].y) + (v[j].z * v[j].z + v[j].w * v[j].w); }
            const float r = 1.0f / sqrtf(wave_sum(s) * (1.0f / D) + EPS);
            const f32x4* gr = (const f32x4*)in[25] + lane; f32x4* orow = (f32x4*)(args.out + (size_t)t * D) + lane;
#pragma unroll
            for (int j = 0; j < 8; ++j) orow[64 * j] = v[j] * r * gr[64 * j];
            if (DBGCHK) {
                const unsigned dv = xb_ld(ctl + CW_DBG); const int code = dv ? 100 - (int)dv : 0;
                const float tab[13] = {1.f, 0.f, 0.5f, 2.f, 3.f, 4.f, 6.f, 10.f, 16.f, 30.f, 60.f, 120.f, 250.f};
                float sc = 1.f;
#pragma unroll
                for (int q = 0; q < 13; ++q) sc = (code == q) ? tab[q] : sc;
                if (code == 8) sc = 2.0f + 10.0f * (float)xb_ld(ctl + CW_DBG + 1) / 512.0f + 100.0f * (float)xb_ld(ctl + CW_DBG + 2) / 512.0f;
                const f32x4* x0 = (const f32x4*)(in[0] + (size_t)t * D) + lane; f32x4 xv[8]; float s2 = 0.f;
#pragma unroll
                for (int j = 0; j < 8; ++j) { xv[j] = x0[64 * j]; s2 += (xv[j].x * xv[j].x + xv[j].y * xv[j].y) + (xv[j].z * xv[j].z + xv[j].w * xv[j].w); }
                const float r2 = 1.0f / sqrtf(wave_sum(s2) * (1.0f / D) + EPS);
#pragma unroll
                for (int j = 0; j < 8; ++j) orow[64 * j] = xv[j] * (r2 * sc) * gr[64 * j];
            }
        }
    }
#undef IN
#undef SEAM
}

extern "C" void kernel_launch(void* const* d_in, const int* in_sizes, int n_in, void* d_out, int out_size, void* d_ws, size_t ws_size, hipStream_t stream) {
    static int grid = 0;
    if (grid == 0) {
        if (n_in != 26 || in_sizes[0] != T * D || out_size != T * D || ws_size < WS_END) { fprintf(stderr, "kernel_launch: unexpected shapes (n_in %d, in0 %d, out %d, ws %zu); nothing launched\n", n_in, n_in > 0 ? in_sizes[0] : -1, out_size, ws_size); grid = -1; return; }
        int dev = 0, cus = 0, per_cu = 0;
        if (hipGetDevice(&dev) != hipSuccess || hipDeviceGetAttribute(&cus, hipDeviceAttributeMultiprocessorCount, dev) != hipSuccess) { fprintf(stderr, "kernel_launch: device query failed\n"); grid = -1; return; }
        if (hipFuncSetAttribute((const void*)fwd_kernel, hipFuncAttributeMaxDynamicSharedMemorySize, LDS_BYTES) != hipSuccess) { fprintf(stderr, "kernel_launch: hipFuncSetAttribute failed\n"); grid = -1; return; }
        if (hipOccupancyMaxActiveBlocksPerMultiprocessor(&per_cu, (const void*)fwd_kernel, NWAVES * 64, LDS_BYTES) != hipSuccess || per_cu < 1) { fprintf(stderr, "kernel_launch: occupancy query reports %d workgroups per CU\n", per_cu); per_cu = 1; }
        (void)hipGetLastError();
        grid = cus;
    }
    if (grid < 0) return;
    if (hipMemsetAsync((char*)d_ws + WS_CTL, 0, CTL_ZERO_BYTES, stream) != hipSuccess) { fprintf(stderr, "kernel_launch: hipMemsetAsync failed\n"); return; }
    Args a{};
    for (int i = 0; i < 26; ++i) a.in[i] = (const float*)d_in[i];
    a.out = (float*)d_out; a.ws = (unsigned char*)d_ws;
    for (int li = 0; li < MK_N_LAUNCHES; ++li) {
        if (MK_N_LAUNCHES == 1) { a.ph_lo = 0; a.ph_hi = 12; } else { a.ph_lo = li; a.ph_hi = li + 1; }
        hipLaunchKernelGGL(fwd_kernel, dim3(grid), dim3(NWAVES * 64), LDS_BYTES, stream, a);
        const hipError_t le = hipPeekAtLastError();
        if (le != hipSuccess) { fprintf(stderr, "kernel_launch: launch %d failed: %s\n", li, hipGetErrorName(le)); break; }
        if (DBGCHK && MK_N_LAUNCHES > 1 && li <= 6) { Args c = a; c.ph_lo = 0; c.ph_hi = 0; c.chk = li + 1; hipLaunchKernelGGL(fwd_kernel, dim3(8), dim3(NWAVES * 64), LDS_BYTES, stream, c); }
    }
}
```

```cpp
#include <hip/hip_runtime.h>
#include <cstdio>
#include <cstdint>

#ifndef MK_N_LAUNCHES
#define MK_N_LAUNCHES 1
#endif

#ifndef DBG
#define DBG 0
#endif
#define LAS __attribute__((address_space(3)))
#define GAS __attribute__((address_space(1)))
typedef _Float16 h16;
typedef _Float16 h16x8 __attribute__((ext_vector_type(8)));
typedef _Float16 h16x4 __attribute__((ext_vector_type(4)));
typedef _Float16 h16x2 __attribute__((ext_vector_type(2)));
typedef float f32x2 __attribute__((ext_vector_type(2)));
typedef float f32x4 __attribute__((ext_vector_type(4)));
typedef float f32x16 __attribute__((ext_vector_type(16)));
typedef unsigned u32x2 __attribute__((ext_vector_type(2)));
typedef unsigned u32x4 __attribute__((ext_vector_type(4)));
typedef short s16x4 __attribute__((ext_vector_type(4)));

constexpr int T = 8192, D = 2048;
constexpr int QKV = 1536, SSMW = 1024, INC = 9728;
constexpr int COL_K = 1536, COL_V = 3072, COL_U = 4608, COL_G = 5632;
constexpr int NE = 32, FF = 512;
constexpr float EPS = 1e-6f;
constexpr float LOG2E = 1.4426950408889634f, LN2 = 0.6931471805599453f;

constexpr size_t MiB = 1u << 20;
constexpr size_t WS_CTL = 0, CTL_ZERO_BYTES = 64 * 1024;
constexpr size_t WS_AB = 1 * MiB;
constexpr size_t WS_BB = WS_AB + 256 * 1024;
constexpr size_t WS_CT = WS_BB + 256 * 1024;
constexpr size_t WS_LSE = 2 * MiB;
constexpr size_t WS_ROUTI = 3 * MiB;
constexpr size_t WS_ROUTF = WS_ROUTI + 128 * 1024;
constexpr size_t WS_TOKROW = WS_ROUTF + 128 * 1024;
constexpr size_t WS_TILEE = WS_TOKROW + 64 * 1024;
constexpr size_t WS_WR = 4 * MiB;
constexpr size_t WS_S = 8 * MiB;
constexpr size_t WS_WIN = 12 * MiB;
constexpr size_t WS_H = 50 * MiB;
constexpr size_t WS_X1 = 12 * MiB;
constexpr size_t WS_WGLU = 82 * MiB;
constexpr size_t WS_WUP = 84 * MiB;
constexpr size_t WS_WOUT = 90 * MiB;
constexpr size_t WS_WGU = 98 * MiB;
constexpr size_t WS_WDN = 226 * MiB;
constexpr size_t WS_PROJ = 290 * MiB;
constexpr size_t WS_OG = 442 * MiB;
constexpr size_t WS_YG = 466 * MiB;
constexpr size_t WS_ACAT = 482 * MiB;
constexpr size_t WS_MERGED = 442 * MiB;
constexpr size_t WS_XS = 290 * MiB;
constexpr size_t WS_HID = 386 * MiB;
constexpr size_t WS_Y = 410 * MiB;
constexpr size_t WS_END = 506 * MiB;
constexpr int MAXTILES = 96;
constexpr int CAP = 768, CAPT = CAP / 256;
constexpr size_t WS_OVF = WS_TILEE + 4096;
constexpr int MAXOVF = 2 * T;
constexpr int CW_BAR = 4096;
constexpr int CW_CNT = 8192;
constexpr int CW_OVF = 8192 + 64 * 32;

namespace pg8 {
constexpr int BM = 256, BK = 64, HALF = 128, HTB = HALF * BK * 2, STAGE_BYTES = 8 * HTB, NXCD = 8, WGM = 8;
__host__ __device__ __forceinline__ int lds_byte(int r, int c) { const int st = (r >> 4) * 2 + (c >> 5), rr = r & 15, cc = c & 31, ob = rr * 64 + cc * 2; return st * 1024 + (ob ^ (((ob >> 9) & 1) << 5)); }
__host__ __device__ __forceinline__ void stage_rc(int b, int& R, int& C) { const int st = b / 1024, sb = b % 1024, swz = sb ^ (((sb >> 9) & 1) << 5); R = (st >> 1) * 16 + swz / 64; C = (st & 1) * 32 + (swz % 64) / 2; }
__host__ __device__ __forceinline__ int perm32(int rho) { const int n = rho >> 4, i = rho & 15; return 8 * (i >> 2) + 4 * n + (i & 3); }

struct Unit { int pm, pn; size_t boff; int half; };
struct Gemm { const h16* A; const h16* Bt; int K; size_t b_hstep; };

struct StaticOrder {
    int nM, nN, nwg, G, c, K;
    __device__ void init(int M, int N, int K_, int G_, int c_) { nM = M / BM; nN = N / BM; nwg = nM * nN; G = G_; c = c_; K = K_; }
    __device__ bool next(int i, Unit& u) const {
        const long L = (long)i * G + c; if (L >= nwg) return false;
        int wgid = (int)L; { const int q = nwg / NXCD, r = nwg % NXCD, xcd = wgid % NXCD, off = wgid / NXCD; wgid = (xcd < r ? xcd * (q + 1) : r * (q + 1) + (xcd - r) * q) + off; }
        const int nig = WGM * nN, gid = wgid / nig, fm = gid * WGM, gsz = (nM - fm) < WGM ? (nM - fm) : WGM;
        u.pm = fm + ((wgid % nig) % gsz); u.pn = (wgid % nig) / gsz; u.boff = (size_t)u.pn * BM * K * 2; u.half = 0; return true;
    }
};
struct ExpertOrder {
    const LAS int* tl; int NT, G, c; size_t e_bytes, pn_bytes;
    __device__ bool next(int i, Unit& u) const {
        const int x = c & 7, off = i * (G >> 3) + (c >> 3), ti = off / NT; if (ti >= tl[8 + x]) return false;
        const int ent = tl[16 + tl[x] + ti]; u.pm = ent & 0xffff; u.half = ent >> 16; u.pn = off % NT;
        const int e = u.pm / CAPT; u.boff = (size_t)e * e_bytes + (size_t)u.pn * pn_bytes; return true;
    }
};
__device__ __forceinline__ unsigned pk2(float lo, float hi) { f32x2 v = {lo, hi}; h16x2 h = __builtin_convertvector(v, h16x2); return __builtin_bit_cast(unsigned, h); }
__device__ __forceinline__ float sigmoidf_(float x) { return __builtin_amdgcn_rcpf(1.0f + __builtin_amdgcn_exp2f(-x * LOG2E)); }
__device__ __forceinline__ h16x2 as_h2(unsigned u) { return __builtin_bit_cast(h16x2, u); }
__device__ __forceinline__ f32x4 h4_to_f4(u32x2 w) { const h16x2 a = as_h2(w.x), b = as_h2(w.y); return (f32x4){(float)a.x, (float)a.y, (float)b.x, (float)b.y}; }

typedef f32x4 Acc[2][2][4][2];

struct EpiProj {
    static constexpr bool PERM = true; static constexpr int HOOK_T = -1;
    h16* O; const float* bgate;
    __device__ __forceinline__ void mid(Acc&, const Unit&, int, int, int, int) const {}
    __device__ __forceinline__ void operator()(const Acc& acc, const Unit& u, int wr, int wc, int fr, int fq) const {
        const int row0 = u.pm * BM + wr * 64 + fr, col0 = u.pn * BM + wc * 32 + 8 * fq;
        const bool isg = __builtin_amdgcn_readfirstlane(u.pn) >= COL_G / BM;
        if (isg) {
            f32x4 bb[2][2];
#pragma unroll
            for (int bj = 0; bj < 2; ++bj) { bb[bj][0] = *(const f32x4*)(bgate + col0 - COL_G + bj * HALF); bb[bj][1] = *(const f32x4*)(bgate + col0 - COL_G + bj * HALF + 4); }
#pragma unroll
            for (int ai = 0; ai < 2; ++ai)
#pragma unroll
                for (int m = 0; m < 4; ++m)
#pragma unroll
                    for (int bj = 0; bj < 2; ++bj) {
                        f32x4 v0 = acc[ai][bj][m][0] + bb[bj][0], v1 = acc[ai][bj][m][1] + bb[bj][1];
#pragma unroll
                        for (int e = 0; e < 4; ++e) { v0[e] = sigmoidf_(v0[e]); v1[e] = sigmoidf_(v1[e]); }
                        u32x4 w; w.x = pk2(v0[0], v0[1]); w.y = pk2(v0[2], v0[3]); w.z = pk2(v1[0], v1[1]); w.w = pk2(v1[2], v1[3]);
                        *(u32x4*)(O + (size_t)(row0 + ai * HALF + m * 16) * INC + col0 + bj * HALF) = w; }
        } else {
#pragma unroll
            for (int ai = 0; ai < 2; ++ai)
#pragma unroll
                for (int m = 0; m < 4; ++m)
#pragma unroll
                    for (int bj = 0; bj < 2; ++bj) {
                        const f32x4 v0 = acc[ai][bj][m][0], v1 = acc[ai][bj][m][1];
                        u32x4 w; w.x = pk2(v0[0], v0[1]); w.y = pk2(v0[2], v0[3]); w.z = pk2(v1[0], v1[1]); w.w = pk2(v1[2], v1[3]);
                        *(u32x4*)(O + (size_t)(row0 + ai * HALF + m * 16) * INC + col0 + bj * HALF) = w; }
        }
    }
};
struct EpiGlu {
    static constexpr bool PERM = true; static constexpr int HOOK_T = -1;
    const h16* YG; h16* ACAT; const float* bglu;
    __device__ __forceinline__ void mid(Acc&, const Unit&, int, int, int, int) const {}
    __device__ __forceinline__ void operator()(const Acc& acc, const Unit& u, int wr, int wc, int fr, int fq) const {
        const int row0 = u.pm * BM + wr * 64 + fr, col0 = u.pn * BM + wc * 32 + 8 * fq;
        f32x4 bb[2][2]; u32x4 yw[4][2], yn[4][2];
#pragma unroll
        for (int bj = 0; bj < 2; ++bj) { bb[bj][0] = *(const f32x4*)(bglu + col0 + bj * HALF); bb[bj][1] = *(const f32x4*)(bglu + col0 + bj * HALF + 4); }
#pragma unroll
        for (int m = 0; m < 4; ++m)
#pragma unroll
            for (int bj = 0; bj < 2; ++bj) yw[m][bj] = *(const u32x4*)(YG + (size_t)(row0 + m * 16) * SSMW + col0 + bj * HALF);
#pragma unroll
        for (int ai = 0; ai < 2; ++ai) {
            u32x4 wv[4][2];
#pragma unroll
            for (int m = 0; m < 4; ++m)
#pragma unroll
                for (int bj = 0; bj < 2; ++bj) {
                    const u32x4 q = yw[m][bj];
                    const f32x4 y0 = h4_to_f4((u32x2){q.x, q.y}), y1 = h4_to_f4((u32x2){q.z, q.w});
                    f32x4 v0 = acc[ai][bj][m][0] + bb[bj][0], v1 = acc[ai][bj][m][1] + bb[bj][1];
#pragma unroll
                    for (int e = 0; e < 4; ++e) { v0[e] = y0[e] * sigmoidf_(v0[e]); v1[e] = y1[e] * sigmoidf_(v1[e]); }
                    u32x4 w; w.x = pk2(v0[0], v0[1]); w.y = pk2(v0[2], v0[3]); w.z = pk2(v1[0], v1[1]); w.w = pk2(v1[2], v1[3]);
                    if (DBG & 2) w = (u32x4){0u, 0u, 0u, 0u};
                    wv[m][bj] = w; }
            if (ai == 0) {
#pragma unroll
                for (int m = 0; m < 4; ++m)
#pragma unroll
                    for (int bj = 0; bj < 2; ++bj) yn[m][bj] = *(const u32x4*)(YG + (size_t)(row0 + HALF + m * 16) * SSMW + col0 + bj * HALF);
            }
#pragma unroll
            for (int m = 0; m < 4; ++m)
#pragma unroll
                for (int bj = 0; bj < 2; ++bj) *(u32x4*)(ACAT + (size_t)(row0 + ai * HALF + m * 16) * 1536 + 512 + col0 + bj * HALF) = wv[m][bj];
#pragma unroll
            for (int m = 0; m < 4; ++m)
#pragma unroll
                for (int bj = 0; bj < 2; ++bj) yw[m][bj] = yn[m][bj];
        }
    }
};
struct EpiUp {
    static constexpr bool PERM = true; static constexpr int HOOK_T = 8;
    const h16* PROJ; h16* O;
    __device__ __forceinline__ void mid(Acc& acc, const Unit& u, int wr, int wc, int fr, int fq) const {
        int row0 = u.pm * BM + wr * 64 + fr, col0 = u.pn * BM + wc * 32 + 8 * fq;
        asm volatile("" : "+v"(row0), "+v"(col0));
#pragma unroll
        for (int ai = 0; ai < 2; ++ai) {
            u32x4 ga[4][2], gs[4][2];
#pragma unroll
            for (int m = 0; m < 4; ++m)
#pragma unroll
                for (int bj = 0; bj < 2; ++bj) { const h16* gp = PROJ + (size_t)(row0 + ai * HALF + m * 16) * INC + COL_G + col0 + bj * HALF; ga[m][bj] = *(const u32x4*)gp; gs[m][bj] = *(const u32x4*)(gp + D); }
#pragma unroll
            for (int m = 0; m < 4; ++m)
#pragma unroll
                for (int bj = 0; bj < 2; ++bj) {
                    const u32x4 a = ga[m][bj], q = gs[m][bj];
                    const f32x4 a0 = h4_to_f4((u32x2){a.x, a.y}), a1 = h4_to_f4((u32x2){a.z, a.w}), s0 = h4_to_f4((u32x2){q.x, q.y}), s1 = h4_to_f4((u32x2){q.z, q.w});
#pragma unroll
                    for (int e = 0; e < 4; ++e) { acc[ai][bj][m][0][e] *= a0[e] * __builtin_amdgcn_rcpf(s0[e]); acc[ai][bj][m][1][e] *= a1[e] * __builtin_amdgcn_rcpf(s1[e]); }
                }
            asm volatile("" ::: "memory");
        }
    }
    __device__ __forceinline__ void operator()(const Acc& acc, const Unit& u, int wr, int wc, int fr, int fq) const {
        const int row0 = u.pm * BM + wr * 64 + fr, col0 = u.pn * BM + wc * 32 + 8 * fq;
        u32x4 gs[4][2], gn[4][2];
#pragma unroll
        for (int m = 0; m < 4; ++m)
#pragma unroll
            for (int bj = 0; bj < 2; ++bj) gs[m][bj] = *(const u32x4*)(PROJ + (size_t)(row0 + m * 16) * INC + COL_G + D + col0 + bj * HALF);
#pragma unroll
        for (int ai = 0; ai < 2; ++ai) {
            u32x4 wv[4][2];
#pragma unroll
            for (int m = 0; m < 4; ++m)
#pragma unroll
                for (int bj = 0; bj < 2; ++bj) {
                    const u32x4 q = gs[m][bj];
                    const f32x4 s0 = h4_to_f4((u32x2){q.x, q.y}), s1 = h4_to_f4((u32x2){q.z, q.w});
                    const f32x4 v0 = acc[ai][bj][m][0] * s0, v1 = acc[ai][bj][m][1] * s1;
                    u32x4 w; w.x = pk2(v0[0], v0[1]); w.y = pk2(v0[2], v0[3]); w.z = pk2(v1[0], v1[1]); w.w = pk2(v1[2], v1[3]);
                    wv[m][bj] = w; }
            if (ai == 0) {
#pragma unroll
                for (int m = 0; m < 4; ++m)
#pragma unroll
                    for (int bj = 0; bj < 2; ++bj) gn[m][bj] = *(const u32x4*)(PROJ + (size_t)(row0 + HALF + m * 16) * INC + COL_G + D + col0 + bj * HALF);
            }
#pragma unroll
            for (int m = 0; m < 4; ++m)
#pragma unroll
                for (int bj = 0; bj < 2; ++bj) *(u32x4*)(O + (size_t)(row0 + ai * HALF + m * 16) * D + col0 + bj * HALF) = wv[m][bj];
#pragma unroll
            for (int m = 0; m < 4; ++m)
#pragma unroll
                for (int bj = 0; bj < 2; ++bj) gs[m][bj] = gn[m][bj];
        }
    }
};
struct EpiOut {
    static constexpr bool PERM = false; static constexpr int HOOK_T = -1;
    const float* X; float* X1;
    __device__ __forceinline__ void mid(Acc&, const Unit&, int, int, int, int) const {}
    __device__ __forceinline__ void operator()(const Acc& acc, const Unit& u, int wr, int wc, int fr, int fq) const {
        const int row0 = u.pm * BM + wr * 64 + fr, col0 = u.pn * BM + wc * 32 + 4 * fq;
        f32x4 cur[2][2], nxt[2][2];
#pragma unroll
        for (int bj = 0; bj < 2; ++bj)
#pragma unroll
            for (int n = 0; n < 2; ++n) cur[bj][n] = *(const f32x4*)(X + (size_t)row0 * D + col0 + bj * HALF + n * 16);
#pragma unroll
        for (int gi = 0; gi < 8; ++gi) {
            const int ai = gi >> 2, m = gi & 3; const size_t off = (size_t)(row0 + ai * HALF + m * 16) * D + col0;
            if (gi < 7) { const int ai2 = (gi + 1) >> 2, m2 = (gi + 1) & 3; const size_t off2 = (size_t)(row0 + ai2 * HALF + m2 * 16) * D + col0;
#pragma unroll
                for (int bj = 0; bj < 2; ++bj)
#pragma unroll
                    for (int n = 0; n < 2; ++n) nxt[bj][n] = *(const f32x4*)(X + off2 + bj * HALF + n * 16); }
#pragma unroll
            for (int bj = 0; bj < 2; ++bj)
#pragma unroll
                for (int n = 0; n < 2; ++n) *(f32x4*)(X1 + off + bj * HALF + n * 16) = cur[bj][n] + acc[ai][bj][m][n];
#pragma unroll
            for (int bj = 0; bj < 2; ++bj)
#pragma unroll
                for (int n = 0; n < 2; ++n) cur[bj][n] = nxt[bj][n];
        }
    }
};
struct EpiGateUp {
    static constexpr bool PERM = true; static constexpr int HOOK_T = -1;
    h16* HID;
    __device__ __forceinline__ void mid(Acc&, const Unit&, int, int, int, int) const {}
    __device__ __forceinline__ void operator()(const Acc& acc, const Unit& u, int wr, int wc, int fr, int fq) const {
        const int row0 = u.pm * BM + wr * 64 + fr, col0 = u.pn * HALF + wc * 32 + 8 * fq;
#pragma unroll
        for (int ai = 0; ai < 2; ++ai) if (ai == 0 || !u.half)
#pragma unroll
            for (int m = 0; m < 4; ++m) {
                f32x4 v[2];
#pragma unroll
                for (int n = 0; n < 2; ++n)
#pragma unroll
                    for (int e = 0; e < 4; ++e) { const float g = acc[ai][0][m][n][e]; v[n][e] = g * sigmoidf_(g) * acc[ai][1][m][n][e]; }
                u32x4 w; w.x = pk2(v[0][0], v[0][1]); w.y = pk2(v[0][2], v[0][3]); w.z = pk2(v[1][0], v[1][1]); w.w = pk2(v[1][2], v[1][3]);
                *(u32x4*)(HID + (size_t)(row0 + ai * HALF + m * 16) * FF + col0) = w; }
    }
};
struct EpiDown {
    static constexpr bool PERM = true; static constexpr int HOOK_T = -1;
    h16* Y;
    __device__ __forceinline__ void mid(Acc&, const Unit&, int, int, int, int) const {}
    __device__ __forceinline__ void operator()(const Acc& acc, const Unit& u, int wr, int wc, int fr, int fq) const {
        const int row0 = u.pm * BM + wr * 64 + fr, col0 = u.pn * BM + wc * 32 + 8 * fq;
#pragma unroll
        for (int ai = 0; ai < 2; ++ai) if (ai == 0 || !u.half)
#pragma unroll
            for (int m = 0; m < 4; ++m)
#pragma unroll
                for (int bj = 0; bj < 2; ++bj) {
                    const f32x4 v0 = acc[ai][bj][m][0], v1 = acc[ai][bj][m][1];
                    u32x4 w; w.x = pk2(v0[0], v0[1]); w.y = pk2(v0[2], v0[3]); w.z = pk2(v1[0], v1[1]); w.w = pk2(v1[2], v1[3]);
                    *(u32x4*)(Y + (size_t)(row0 + ai * HALF + m * 16) * D + col0 + bj * HALF) = w; }
    }
};

struct NoSide { __device__ __forceinline__ void issue() {} __device__ __forceinline__ void fin_a(bool) {} __device__ __forceinline__ void fin_b() {} __device__ __forceinline__ void drain() {} };
struct ConvSide {
    const float* Wg; const float* Wu; const float* Wd; unsigned char* ws; LAS unsigned char* scr; int it, stride, lane, pend;
    f32x4 v0, v1, v2, v3; u32x2 t0, t1, t2, t3;
    static constexpr int NITEMS = 3 * 32768;
    __device__ __forceinline__ void locate(int item, const float*& src, int& N, h16*& dst, int& ldo) const {
        if (item < 65536) { const int up = item >> 15, r = item & 32767, e = r >> 10, kb = (r >> 4) & 63, nb = r & 15;
            src = (up ? Wu : Wg) + ((size_t)e * 2048 + 32 * kb) * 512 + 32 * nb; N = 512; dst = (h16*)(ws + WS_WGU) + ((size_t)e * 1024 + up * 512 + 32 * nb) * 2048 + 32 * kb; ldo = 2048; }
        else { const int r = item - 65536, e = r >> 10, kb = (r >> 6) & 15, nb = r & 63;
            src = Wd + ((size_t)e * 512 + 32 * kb) * 2048 + 32 * nb; N = 2048; dst = (h16*)(ws + WS_WDN) + ((size_t)e * 2048 + 32 * nb) * 512 + 32 * kb; ldo = 512; }
    }
    __device__ __forceinline__ void issue() {
        pend = 0;
        if (it < NITEMS) {
            const float* src; int N; h16* dst; int ldo; locate(it, src, N, dst, ldo);
            const unsigned o0 = (unsigned)(((lane >> 3) * N + (lane & 7) * 4) * 4);
            const float* s1 = src + (size_t)8 * N; const float* s2 = s1 + (size_t)8 * N; const float* s3 = s2 + (size_t)8 * N;
            asm volatile("global_load_dwordx4 %0, %4, %5 nt\n\tglobal_load_dwordx4 %1, %4, %6 nt\n\tglobal_load_dwordx4 %2, %4, %7 nt\n\tglobal_load_dwordx4 %3, %4, %8 nt"
                         : "=&v"(v0), "=&v"(v1), "=&v"(v2), "=&v"(v3) : "v"(o0), "s"(src), "s"(s1), "s"(s2), "s"(s3) : "memory");
            pend = 1;
        }
    }
    __device__ __forceinline__ void fin_a(bool all) {
        if (pend) {
            if (all) asm volatile("s_waitcnt vmcnt(0)" : "+v"(v0), "+v"(v1), "+v"(v2), "+v"(v3) :: "memory");
            else     asm volatile("s_waitcnt vmcnt(8)" : "+v"(v0), "+v"(v1), "+v"(v2), "+v"(v3) :: "memory");
            { u32x2 p; p.x = pk2(v0.x, v0.y); p.y = pk2(v0.z, v0.w); *(LAS u32x2*)(scr + ((lane >> 3)) * 72 + (lane & 7) * 8) = p; }
            { u32x2 p; p.x = pk2(v1.x, v1.y); p.y = pk2(v1.z, v1.w); *(LAS u32x2*)(scr + ((lane >> 3) + 8) * 72 + (lane & 7) * 8) = p; }
            { u32x2 p; p.x = pk2(v2.x, v2.y); p.y = pk2(v2.z, v2.w); *(LAS u32x2*)(scr + ((lane >> 3) + 16) * 72 + (lane & 7) * 8) = p; }
            { u32x2 p; p.x = pk2(v3.x, v3.y); p.y = pk2(v3.z, v3.w); *(LAS u32x2*)(scr + ((lane >> 3) + 24) * 72 + (lane & 7) * 8) = p; }
            const int g = lane >> 4, i = lane & 15, nh = g & 1, kh = g >> 1;
            const unsigned ra = (unsigned)(size_t)(scr + (16 * kh + (i >> 2)) * 72 + (16 * nh + 4 * (i & 3)) * 2);
            asm volatile("ds_read_b64_tr_b16 %0, %4\n\tds_read_b64_tr_b16 %1, %4 offset:288\n\tds_read_b64_tr_b16 %2, %4 offset:576\n\tds_read_b64_tr_b16 %3, %4 offset:864"
                         : "=&v"(t0), "=&v"(t1), "=&v"(t2), "=&v"(t3) : "v"(ra) : "memory");
        }
    }
    __device__ __forceinline__ void fin_b() {
        if (pend) {
            asm volatile("s_waitcnt lgkmcnt(0)" : "+v"(t0), "+v"(t1), "+v"(t2), "+v"(t3) :: "memory");
            const float* src; int N; h16* dst; int ldo; locate(it, src, N, dst, ldo);
            const int g = lane >> 4, i = lane & 15, nh = g & 1, kh = g >> 1;
            const u32x4 o0 = {t0.x, t0.y, t1.x, t1.y}, o1 = {t2.x, t2.y, t3.x, t3.y};
            h16* dp = dst + (size_t)(16 * nh + i) * ldo + 16 * kh;
            __builtin_nontemporal_store(o0, (u32x4*)dp); __builtin_nontemporal_store(o1, (u32x4*)(dp + 8));
            it += stride; pend = 0;
        }
    }
    __device__ __forceinline__ void drain() { while (it < NITEMS) { issue(); fin_a(true); fin_b(); } }
};

template <class Epi, class Sched, bool ALIGN_EPI = true, bool HALFSKIP = false, class Side = NoSide>
__device__ __forceinline__ void gemm_phase(LAS unsigned char* lds, const Gemm g, const Sched& S, const Epi& E, Side side = Side()) {
    const int tid = threadIdx.x, wid = __builtin_amdgcn_readfirstlane(tid >> 6), lane = tid & 63, wr = wid >> 2, wc = wid & 3, fr = lane & 15, fq = lane >> 4;
    const int K = g.K, nt = K / BK;
    unsigned voffA[2], voffB[2];
#pragma unroll
    for (int i = 0; i < 2; ++i) { int R, C; stage_rc(tid * 16 + i * 8192, R, C); const int Rb = Epi::PERM ? ((R & ~31) + perm32(R & 31)) : R;
        voffA[i] = (unsigned)(R * K + C) * 2u; voffB[i] = (unsigned)(Rb * K + C) * 2u; }
    const size_t kstep = (size_t)(BK * 2);
    const size_t hstepA = (size_t)HALF * K * 2, hstepB = g.b_hstep;
    const size_t tstepA = 2 * hstepA;
    const unsigned ldsw = (unsigned)wid * 1024u;
    const int aoff = lds_byte(wr * 64 + fr, fq * 8), boff = lds_byte(wc * 32 + fr, fq * 8);
#define PG8_SA(b, h) (((b) * 2 + (h)) * HTB)
#define PG8_SB(b, h) ((4 + (b) * 2 + (h)) * HTB)
#define PG8_STAGE(bufoff, gbase, voff) do { _Pragma("unroll") for (int _i = 0; _i < 2; ++_i) \
        __builtin_amdgcn_global_load_lds((const unsigned*)((const char*)(gbase) + (voff)[_i]), (LAS unsigned*)(lds + (bufoff) + ldsw + _i * 8192), 16, 0, 0); } while (0)
#define PG8_LDA(dst, b, h) do { _Pragma("unroll") for (int m = 0; m < 4; ++m) _Pragma("unroll") for (int k = 0; k < 2; ++k) dst[m][k] = *(const LAS h16x8*)(lds + PG8_SA(b, h) + aoff + m * 2048 + k * 1024); } while (0)
#define PG8_LDB(dst, b, h) do { _Pragma("unroll") for (int n = 0; n < 2; ++n) _Pragma("unroll") for (int k = 0; k < 2; ++k) dst[n][k] = *(const LAS h16x8*)(lds + PG8_SB(b, h) + boff + n * 2048 + k * 1024); } while (0)
#define PG8_MMA(ai, bj, At, Bt) do { __builtin_amdgcn_s_setprio(1); _Pragma("unroll") for (int m = 0; m < 4; ++m) _Pragma("unroll") for (int n = 0; n < 2; ++n) _Pragma("unroll") for (int k = 0; k < 2; ++k) \
        acc[ai][bj][m][n] = __builtin_amdgcn_mfma_f32_16x16x32_f16(Bt[n][k], At[m][k], acc[ai][bj][m][n], 0, 0, 0); __builtin_amdgcn_s_setprio(0); } while (0)
#define PG8_WAIT_V(n) asm volatile("s_waitcnt vmcnt(" #n ")" ::: "memory")
#define PG8_WAIT_L(n) asm volatile("s_waitcnt lgkmcnt(" #n ")" ::: "memory")
#define PG8_BAR __builtin_amdgcn_s_barrier()
#define PG8_SCHED __builtin_amdgcn_sched_barrier(0)
    Unit cur, nxt; int ui = 0;
    if (!S.next(0, cur)) { side.drain(); return; }
    Acc acc;
#pragma unroll
    for (int a = 0; a < 2; ++a)
#pragma unroll
        for (int b = 0; b < 2; ++b)
#pragma unroll
            for (int m = 0; m < 4; ++m)
#pragma unroll
                for (int n = 0; n < 2; ++n) acc[a][b][m][n] = (f32x4){0.f, 0.f, 0.f, 0.f};
    h16x8 At[4][2], B0[2][2], B1[2][2];
    const char* cA = (const char*)g.A + (size_t)cur.pm * tstepA; const char* cB = (const char*)g.Bt + cur.boff;
    PG8_STAGE(PG8_SB(0, 0), cB, voffB); PG8_STAGE(PG8_SB(0, 1), cB + hstepB, voffB); PG8_STAGE(PG8_SA(0, 0), cA, voffA); PG8_STAGE(PG8_SA(0, 1), cA + hstepA, voffA);
    if (wr == 1) PG8_BAR;
    PG8_WAIT_V(2); PG8_BAR;
    PG8_STAGE(PG8_SB(1, 0), cB + kstep, voffB); PG8_STAGE(PG8_SA(1, 0), cA + kstep, voffA); PG8_STAGE(PG8_SB(1, 1), cB + hstepB + kstep, voffB);
    PG8_WAIT_V(6); PG8_BAR;
    for (;;) {
        const bool has_next = S.next(ui + 1, nxt);
        const bool hf = HALFSKIP && __builtin_amdgcn_readfirstlane(cur.half) != 0;
        const char* nA = has_next ? (const char*)g.A + (size_t)nxt.pm * tstepA : cA; const char* nB = has_next ? (const char*)g.Bt + nxt.boff : cB;
        for (int t = 0; t < nt; t += 2) {
            if (Epi::HOOK_T >= 0 && t == Epi::HOOK_T) E.mid(acc, cur, wr, wc, fr, fq);
            const bool last = (t == nt - 2);
            const char* a1 = cA + (size_t)(t + 1) * kstep;
            const char* a2 = last ? nA : cA + (size_t)(t + 2) * kstep; const char* b2 = last ? nB : cB + (size_t)(t + 2) * kstep;
            const char* a3 = a2 + kstep; const char* b3 = b2 + kstep;
            PG8_LDB(B0, 0, 0); PG8_LDB(B1, 0, 1); PG8_SCHED; PG8_LDA(At, 0, 0); PG8_STAGE(PG8_SA(1, 1), a1 + hstepA, voffA);
            PG8_WAIT_V(8); PG8_WAIT_L(0); PG8_BAR; PG8_MMA(0, 0, At, B0); side.issue(); PG8_MMA(0, 1, At, B1); PG8_BAR; PG8_SCHED;
            if (!hf) PG8_LDA(At, 0, 1); PG8_STAGE(PG8_SB(0, 0), b2, voffB); PG8_STAGE(PG8_SB(0, 1), b2 + hstepB, voffB); PG8_STAGE(PG8_SA(0, 0), a2, voffA);
            PG8_WAIT_V(8); PG8_WAIT_L(0); PG8_BAR; if (!hf) { PG8_MMA(1, 0, At, B0); PG8_MMA(1, 1, At, B1); } PG8_BAR; PG8_SCHED;
            PG8_LDB(B0, 1, 0); PG8_LDB(B1, 1, 1); PG8_SCHED; PG8_LDA(At, 1, 0); PG8_STAGE(PG8_SA(0, 1), a2 + hstepA, voffA);
            PG8_WAIT_V(8); PG8_WAIT_L(0); PG8_BAR; PG8_MMA(0, 0, At, B0); side.fin_a(false); PG8_MMA(0, 1, At, B1); PG8_BAR; PG8_SCHED;
            if (!hf) PG8_LDA(At, 1, 1); PG8_STAGE(PG8_SB(1, 0), b3, voffB); PG8_STAGE(PG8_SB(1, 1), b3 + hstepB, voffB); PG8_STAGE(PG8_SA(1, 0), a3, voffA);
            PG8_WAIT_V(8); PG8_WAIT_L(0); PG8_BAR; if (!hf) PG8_MMA(1, 0, At, B0); side.fin_b(); if (!hf) PG8_MMA(1, 1, At, B1); PG8_BAR; PG8_SCHED;
        }
        if constexpr (ALIGN_EPI) { if (wr == 0) PG8_BAR; }
        E(acc, cur, wr, wc, fr, fq);
        if (!has_next) break;
#pragma unroll
        for (int a = 0; a < 2; ++a)
#pragma unroll
            for (int b = 0; b < 2; ++b)
#pragma unroll
                for (int m = 0; m < 4; ++m)
#pragma unroll
                    for (int n = 0; n < 2; ++n) acc[a][b][m][n] = (f32x4){0.f, 0.f, 0.f, 0.f};
        cur = nxt; cA = nA; cB = nB; ++ui;
        if constexpr (ALIGN_EPI) { if (wr == 1) PG8_BAR; }
    }
    PG8_WAIT_V(0);
    if constexpr (!ALIGN_EPI) { if (wr == 0) PG8_BAR; }
    PG8_BAR;
    side.drain();
#undef PG8_SA
#undef PG8_SB
#undef PG8_STAGE
#undef PG8_LDA
#undef PG8_LDB
#undef PG8_MMA
#undef PG8_WAIT_V
#undef PG8_WAIT_L
#undef PG8_BAR
#undef PG8_SCHED
}
}
using pg8::pk2;

constexpr int NWAVES = 8;
constexpr int RING_BYTES = 131072;
constexpr int LDSCTL_OFF = RING_BYTES, MISC_OFF = LDSCTL_OFF + 320;
constexpr int SIDE_OFF = LDSCTL_OFF + 2048, SIDE_WAVE = 2304;
constexpr int LDS_BYTES = SIDE_OFF + 8 * SIDE_WAVE + 1024;

typedef GAS unsigned gu32;
#define RLX_AGENT __ATOMIC_RELAXED, __HIP_MEMORY_SCOPE_AGENT
#define XB_TMO      128
#define XB_XCNT(j)  (256  + 64 * (j))
#define XB_XSUB(j)  (1280 + 64 * (j))
#define XB_XGEN(j)  (2304 + 64 * (j))
#define XB_TOP      3328
#define XB_TOPGEN   3392
#define XCD_BAR_WORDS 3456
#define XB_SPIN_CAP (1u << 18)
__device__ __forceinline__ unsigned xb_ld(unsigned* p)              { return __hip_atomic_load(p, __ATOMIC_RELAXED, __HIP_MEMORY_SCOPE_AGENT); }
__device__ __forceinline__ unsigned xb_add(unsigned* p, unsigned v) { return __hip_atomic_fetch_add(p, v, __ATOMIC_RELAXED, __HIP_MEMORY_SCOPE_AGENT); }
__device__ __forceinline__ unsigned xb_xcc_id() { return (unsigned)__builtin_amdgcn_s_getreg((3 << 11) | 20) & 0xFu; }
#define XB_SPIN(cond, bar) do { unsigned _sp = 0; while (cond) { __builtin_amdgcn_s_sleep(1); \
    if ((++_sp & 255u) == 0u) { if (xb_ld(&(bar)[XB_TMO])) break; if (_sp > XB_SPIN_CAP) { atomicAdd(&(bar)[XB_TMO], 1u); break; } } } } while (0)
struct XcdBarrier { unsigned* bar; unsigned x; volatile LAS unsigned* st; };
__device__ __forceinline__ XcdBarrier xcd_barrier_post(unsigned* bar, volatile LAS unsigned* st) {
    XcdBarrier b; b.bar = bar; b.x = xb_xcc_id(); b.st = st;
    if (threadIdx.x == 0) (void)xb_add(&bar[XB_XCNT(b.x)], 1u);
    return b;
}
__device__ __forceinline__ void xcd_barrier_complete(unsigned* bar, unsigned x, unsigned& nloc, unsigned& nx) {
    const unsigned G = gridDim.x * gridDim.y * gridDim.z;
    unsigned sum, cnt, mine, sp = 0u;
    for (;;) {
        sum = 0u; cnt = 0u; mine = 0u;
#pragma unroll
        for (unsigned j = 0; j < 16; ++j) { const unsigned c = xb_ld(&bar[XB_XCNT(j)]); sum += c; cnt += (c > 0u) ? 1u : 0u; mine = (j == x) ? c : mine; }
        if (sum == G) break;
        __builtin_amdgcn_s_sleep(1);
        if ((++sp & 255u) == 0u) { if (xb_ld(&bar[XB_TMO])) break; if (sp > XB_SPIN_CAP) { atomicAdd(&bar[XB_TMO], 1u); break; } }
    }
    nloc = mine > 0u ? mine : 1u; nx = cnt > 0u ? cnt : 1u;
}
__device__ __forceinline__ void xcd_barrier(const XcdBarrier& b) {
    asm volatile("s_waitcnt vmcnt(0)" ::: "memory");
    __syncthreads();
    if (threadIdx.x == 0) {
        unsigned* bar = b.bar;
        __builtin_amdgcn_s_waitcnt(0);
        unsigned nloc = b.st[0], nx = b.st[1];
        if (nloc == 0u) { xcd_barrier_complete(bar, b.x, nloc, nx); b.st[0] = nloc; b.st[1] = nx; }
        const unsigned old = xb_add(&bar[XB_XSUB(b.x)], 1u);
        const unsigned gen = old / nloc;
        if (old + 1u == (gen + 1u) * nloc) {
            __builtin_amdgcn_fence(__ATOMIC_RELEASE, "agent");
            asm volatile("s_waitcnt vmcnt(0)" ::: "memory");
            const unsigned og = xb_add(&bar[XB_TOP], 1u);
            const unsigned tg = og / nx;
            if (og + 1u == (tg + 1u) * nx) xb_add(&bar[XB_TOPGEN], 1u);
            else XB_SPIN(xb_ld(&bar[XB_TOPGEN]) == tg, bar);
            __builtin_amdgcn_fence(__ATOMIC_ACQUIRE, "agent");
            xb_add(&bar[XB_XGEN(b.x)], 1u);
            asm volatile("s_waitcnt vmcnt(0)" ::: "memory");
        } else {
            XB_SPIN(xb_ld(&bar[XB_XGEN(b.x)]) == gen, bar);
            __builtin_amdgcn_fence(__ATOMIC_ACQUIRE, "agent");
            asm volatile("s_waitcnt vmcnt(0)" ::: "memory");
        }
    }
    __syncthreads();
}

struct Args { const float* in[26]; float* out; unsigned char* ws; int ph_lo, ph_hi, chk, pad; };
struct Frame {
    LAS unsigned char* lds; unsigned char* ws; int tid, lane, wave, G, gw, NGW;
};
#define LDS_WAIT() asm volatile("s_waitcnt lgkmcnt(0)" ::: "memory")
__device__ __forceinline__ float wave_sum(float v) {
#pragma unroll
    for (int o = 1; o < 64; o <<= 1) v += __shfl_xor(v, o);
    return v;
}
__device__ __forceinline__ float gelu_tanh(float x) {
    const float z = 0.7978845608028654f * (x + 0.044715f * x * x * x);
    const float e = __builtin_amdgcn_exp2f(2.0f * LOG2E * z);
    const float th = 1.0f - 2.0f * __builtin_amdgcn_rcpf(e + 1.0f);
    return 0.5f * x * (1.0f + th);
}

__device__ __forceinline__ void p0_transpose_item(const float* W, int N, h16* WT, int ldo, int koff, int row_off, LAS float* scr, int item, int lane) {
    const int nblk = N / 32, kb = item / nblk, nb = item % nblk, k0 = 64 * kb, n0 = 32 * nb;
#pragma unroll 8
    for (int i = 0; i < 32; ++i) { const int kk = 2 * i + (lane >> 5); scr[kk * 33 + (lane & 31)] = W[(size_t)(k0 + kk) * N + n0 + (lane & 31)]; }
    LDS_WAIT(); asm volatile("" ::: "memory");
    const int c = lane & 7;
#pragma unroll
    for (int j = 0; j < 4; ++j) { const int n = (lane >> 3) + 8 * j; const LAS float* s = scr + (8 * c) * 33 + n;
        u32x4 o; o.x = pk2(s[0 * 33], s[1 * 33]); o.y = pk2(s[2 * 33], s[3 * 33]); o.z = pk2(s[4 * 33], s[5 * 33]); o.w = pk2(s[6 * 33], s[7 * 33]);
        *(u32x4*)(WT + (size_t)(row_off + n0 + n) * ldo + koff + k0 + 8 * c) = o; }
    LDS_WAIT(); asm volatile("" ::: "memory");
}
__device__ __forceinline__ void rms_row_to_h16(const float* xrow, const float* gain, h16* orow, int lane) {
    const f32x4* xr = (const f32x4*)xrow + lane; const f32x4* gr = (const f32x4*)gain + lane;
    f32x4 v[8]; float s = 0.f;
#pragma unroll
    for (int j = 0; j < 8; ++j) { v[j] = xr[64 * j]; s += (v[j].x * v[j].x + v[j].y * v[j].y) + (v[j].z * v[j].z + v[j].w * v[j].w); }
    const float r = 1.0f / sqrtf(wave_sum(s) * (1.0f / D) + EPS);
    u32x2* o8 = (u32x2*)orow + lane;
#pragma unroll
    for (int j = 0; j < 8; ++j) { const f32x4 g = gr[64 * j]; u32x2 w; w.x = pk2(v[j].x * r * g.x, v[j].y * r * g.y); w.y = pk2(v[j].z * r * g.z, v[j].w * r * g.w); o8[64 * j] = w; }
}

template <bool FULL>
__device__ __forceinline__ void ssm_wave(const Frame& F, const float* const* in, LAS unsigned char* wl) {
    unsigned char* ws = F.ws; const int lane = F.lane, lq = lane >> 4, lr = lane & 15;
    const int g = F.gw & 63, jw = F.gw >> 6, nj = F.NGW >> 6;
    const f32x4 ab = ((const f32x4*)(ws + WS_AB))[g * 64 + lane];
    const float ar = ab.x, ai = ab.y;
    const h16* PROJ = (const h16*)(ws + WS_PROJ);
    h16x8 bfrag[8];
    const h16x8 zero8 = {0, 0, 0, 0, 0, 0, 0, 0};
#pragma unroll
    for (int mt = 0; mt < 8; ++mt) bfrag[mt] = lq < 2 ? *(const h16x8*)((const h16*)(ws + WS_BB) + ((size_t)(g * 128 + 16 * mt + lr)) * 16 + 8 * lq) : zero8;
    h16x8 cfrag[4]; f32x4 d4 = {0.f, 0.f, 0.f, 0.f};
    if (FULL) {
#pragma unroll
        for (int s = 0; s < 4; ++s) cfrag[s] = *(const h16x8*)((const h16*)(ws + WS_CT) + ((size_t)(g * 16 + lr)) * 128 + 32 * s + 8 * lq);
        d4 = *(const f32x4*)(in[11] + 16 * g + 4 * lq);
    }
    const f32x2* Sg = (const f32x2*)(ws + WS_S) + (size_t)g * 64 + lane;
    for (int j = jw; j < 128; j += nj) {
        const int c = FULL ? (((j >> 5) & 1) ? ((j & ~31) + 31 - (j & 31)) : j) : j;
        const int t0 = 64 * c;
        h16x8 uf[4]; u32x2 uw[4];
#pragma unroll
        for (int sub = 0; sub < 4; ++sub) {
            uf[sub] = lq < 2 ? *(const h16x8*)(PROJ + (size_t)(t0 + 16 * sub + lr) * INC + COL_U + 16 * g + 8 * lq) : zero8;
            if (FULL) uw[sub] = *(const u32x2*)(PROJ + (size_t)(t0 + 16 * sub + lr) * INC + COL_U + 16 * g + 4 * lq);
        }
        float xr = 0.f, xi = 0.f;
        if (FULL) {
            const float alr = ab.z, ali = ab.w;
#pragma unroll 8
            for (int cc = 0; cc < c; ++cc) { const f32x2 sv = Sg[(size_t)cc * 4096]; const float nr = alr * xr - ali * xi + sv.x, ni = alr * xi + ali * xr + sv.y; xr = nr; xi = ni; }
        }
#pragma unroll
        for (int sub = 0; sub < 4; ++sub) {
            const int ts = t0 + 16 * sub;
#pragma unroll
            for (int mt = 0; mt < 8; ++mt) {
                f32x4 a = {0.f, 0.f, 0.f, 0.f};
                a = __builtin_amdgcn_mfma_f32_16x16x32_f16(bfrag[mt], uf[sub], a, 0, 0, 0);
                *(LAS f32x4*)(wl + lr * 528 + (16 * mt + 4 * lq) * 4) = a;
            }
            f32x2 bu[16];
#pragma unroll
            for (int t = 0; t < 16; ++t) bu[t] = *(const LAS f32x2*)(wl + t * 528 + 8 * lane);
#pragma unroll
            for (int t = 0; t < 16; ++t) {
                const float nr = ar * xr - ai * xi + bu[t].x, ni = ar * xi + ai * xr + bu[t].y; xr = nr; xi = ni;
                if (FULL) *(LAS unsigned*)(wl + t * 528 + 4 * lane) = pk2(xr, xi);
            }
            if (FULL) {
                f32x4 y = {0.f, 0.f, 0.f, 0.f};
#pragma unroll
                for (int s = 0; s < 4; ++s) { const h16x8 xf = *(const LAS h16x8*)(wl + lr * 528 + (32 * s + 8 * lq) * 2); y = __builtin_amdgcn_mfma_f32_16x16x32_f16(cfrag[s], xf, y, 0, 0, 0); }
                const f32x4 u4 = pg8::h4_to_f4(uw[sub]);
                f32x4 o;
#pragma unroll
                for (int e = 0; e < 4; ++e) o[e] = gelu_tanh(y[e] + d4[e] * u4[e]);
                u32x2 w; w.x = pk2(o[0], o[1]); w.y = pk2(o[2], o[3]);
                *(u32x2*)((h16*)(ws + WS_YG) + (size_t)(ts + lr) * SSMW + 16 * g + 4 * lq) = w;
            }
        }
        if (!FULL) ((f32x2*)(ws + WS_S))[(size_t)c * 4096 + g * 64 + lane] = (f32x2){xr, xi};
    }
}

__device__ __forceinline__ s16x4 tr_read(const LAS unsigned char* p) {
    typedef short v4i16_t __attribute__((ext_vector_type(4)));
    return __builtin_amdgcn_ds_read_tr16_b64_v4i16((LAS v4i16_t*)p);
}
__device__ __forceinline__ void attn_pair(const Frame& F, int item0) {
    unsigned char* ws = F.ws; const int tid = F.tid, lane = F.lane, wave = F.wave;
    const int half = wave >> 2, qt = wave & 3, r = lane & 31, hh = lane >> 5;
    const int item = item0 + half;
    const int g = item >> 9, hs = (item >> 6) & 7, blk = item & 63;
    const int dl = (g == 0) ? 0 : (g == 1 ? 2 : 4), dil = 1 << dl, res = blk & (dil - 1), n = blk >> dl;
    const h16* PROJ = (const h16*)(ws + WS_PROJ);
    const int hcol = (g * 8 + hs) * 64;
    LAS unsigned char* vimg = F.lds + half * 32768;
    const int t2 = tid & 255, c8 = t2 & 7;
    u32x4 vst[8];
#pragma unroll
    for (int j = 0; j < 8; ++j) {
        const int kj = (t2 >> 3) + 32 * j, idx = (n - 1) * 128 + kj;
        vst[j] = (u32x4){0u, 0u, 0u, 0u};
        if (idx >= 0) vst[j] = *(const u32x4*)(PROJ + (size_t)(idx * dil + res) * INC + COL_V + hcol + 8 * c8);
    }
    const int qpos = ((n * 128 + 32 * qt + r) << dl) + res;
    h16x8 qf[4];
#pragma unroll
    for (int s = 0; s < 4; ++s) qf[s] = *(const h16x8*)(PROJ + (size_t)qpos * INC + hcol + 16 * s + 8 * hh);
    h16x8 kf[5][4];
#pragma unroll
    for (int k5 = 0; k5 < 5; ++k5) {
        const int kj = 32 * (qt + k5) + r, idx = (n - 1) * 128 + kj, pos = ((idx < 0 ? 0 : idx) << dl) + res;
#pragma unroll
        for (int s = 0; s < 4; ++s) kf[k5][s] = *(const h16x8*)(PROJ + (size_t)pos * INC + COL_K + hcol + 16 * s + 8 * hh);
    }
    __builtin_amdgcn_sched_barrier(0);
#pragma unroll
    for (int j = 0; j < 8; ++j) *(LAS u32x4*)(vimg + ((t2 >> 3) + 32 * j) * 128 + c8 * 16) = vst[j];
    const float c1 = 0.125f * LOG2E, c2 = __builtin_amdgcn_exp2f(-(float)(hs + 1)) * (float)dil * LOG2E;
    float mx = -INFINITY;
    f32x16 sc[5];
#pragma unroll
    for (int k5 = 0; k5 < 5; ++k5) {
        f32x16 a = {0.f, 0.f, 0.f, 0.f, 0.f, 0.f, 0.f, 0.f, 0.f, 0.f, 0.f, 0.f, 0.f, 0.f, 0.f, 0.f};
#pragma unroll
        for (int s = 0; s < 4; ++s) a = __builtin_amdgcn_mfma_f32_32x32x16_f16(kf[k5][s], qf[s], a, 0, 0, 0);
        const int sbase = 128 + r - 32 * k5 - 4 * hh;
        const bool tile_ok = (n > 0) || (qt + k5 >= 4);
        const float fb = -c2 * (float)sbase;
#pragma unroll
        for (int i = 0; i < 16; ++i) {
            const int ci = (i & 3) + 8 * (i >> 2);
            const bool ok = tile_ok && ((unsigned)(sbase - ci) <= 128u);
            const float v = ok ? __builtin_fmaf(a[i], c1, fb + c2 * (float)ci) : -INFINITY;
            a[i] = v; mx = fmaxf(mx, v);
        }
        sc[k5] = a;
    }
    mx = fmaxf(mx, __shfl_xor(mx, 32));
    float l = 0.f;
#pragma unroll
    for (int k5 = 0; k5 < 5; ++k5)
#pragma unroll
        for (int i = 0; i < 16; ++i) { const float p = __builtin_amdgcn_exp2f(sc[k5][i] - mx); sc[k5][i] = p; l += p; }
    l += __shfl_xor(l, 32);
    __syncthreads();
    f32x16 o0 = {0.f, 0.f, 0.f, 0.f, 0.f, 0.f, 0.f, 0.f, 0.f, 0.f, 0.f, 0.f, 0.f, 0.f, 0.f, 0.f}, o1 = o0;
    const int vq = (lane & 15) >> 2, vp = lane & 3, vg = (lane >> 4) & 1;
    const LAS unsigned char* vb = vimg + (4 * hh + vq) * 128 + (16 * vg + 4 * vp) * 2;
#pragma unroll
    for (int k5 = 0; k5 < 5; ++k5)
#pragma unroll
        for (int s = 0; s < 2; ++s) {
            u32x4 pw; pw.x = pk2(sc[k5][8 * s + 0], sc[k5][8 * s + 1]); pw.y = pk2(sc[k5][8 * s + 2], sc[k5][8 * s + 3]); pw.z = pk2(sc[k5][8 * s + 4], sc[k5][8 * s + 5]); pw.w = pk2(sc[k5][8 * s + 6], sc[k5][8 * s + 7]);
            const h16x8 pf = __builtin_bit_cast(h16x8, pw);
            const LAS unsigned char* vr = vb + (32 * (qt + k5) + 16 * s) * 128;
            const s16x4 a0 = tr_read(vr), a1 = tr_read(vr + 8 * 128), b0 = tr_read(vr + 64), b1 = tr_read(vr + 8 * 128 + 64);
            typedef short s16x8 __attribute__((ext_vector_type(8)));
            const s16x8 va = {a0[0], a0[1], a0[2], a0[3], a1[0], a1[1], a1[2], a1[3]}, vbb = {b0[0], b0[1], b0[2], b0[3], b1[0], b1[1], b1[2], b1[3]};
            o0 = __builtin_amdgcn_mfma_f32_32x32x16_f16(__builtin_bit_cast(h16x8, va), pf, o0, 0, 0, 0);
            o1 = __builtin_amdgcn_mfma_f32_32x32x16_f16(__builtin_bit_cast(h16x8, vbb), pf, o1, 0, 0, 0);
        }
    const float il = 1.0f / l;
    h16* og = (h16*)(ws + WS_OG) + ((size_t)g * T + qpos) * 512 + hs * 64;
#pragma unroll
    for (int q4 = 0; q4 < 4; ++q4) {
        u32x2 w; w.x = pk2(o0[4 * q4] * il, o0[4 * q4 + 1] * il); w.y = pk2(o0[4 * q4 + 2] * il, o0[4 * q4 + 3] * il);
        *(u32x2*)(og + 8 * q4 + 4 * hh) = w;
        w.x = pk2(o1[4 * q4] * il, o1[4 * q4 + 1] * il); w.y = pk2(o1[4 * q4 + 2] * il, o1[4 * q4 + 3] * il);
        *(u32x2*)(og + 32 + 8 * q4 + 4 * hh) = w;
    }
    if (hh == 0) ((float*)(ws + WS_LSE))[((size_t)g * T + qpos) * 8 + hs] = mx * LN2 + __logf(l);
    __syncthreads();
}


#ifndef DBGCHK
#define DBGCHK 0
#endif
constexpr int CW_DBG = 12288;
__device__ __forceinline__ unsigned hsh(unsigned x) { x ^= x >> 16; x *= 0x7feb352du; x ^= x >> 15; x *= 0x846ca68bu; x ^= x >> 16; return x; }
__device__ __forceinline__ void chk_fail(unsigned* ctl, int code) { atomicMax(ctl + CW_DBG, (unsigned)(100 - code)); }
__device__ __forceinline__ bool close_(float a, float b) { return fabsf(a - b) <= 0.01f * fabsf(b) + 0.01f && a == a; }
__device__ __forceinline__ float dot_hh(const h16* a, const h16* b, int K) { float s = 0.f; for (int k = 0; k < K; ++k) s += (float)a[k] * (float)b[k]; return s; }
__device__ __forceinline__ void run_checks(int after, const float* const* in, unsigned char* ws, unsigned* ctl, int tid) {
    const unsigned r0 = hsh(tid * 7919u + after * 104729u + 12345u), r1 = hsh(r0 + 1u), r2 = hsh(r1 + 7u);
    const h16* PROJ = (const h16*)(ws + WS_PROJ);
    if (after == 0) {
        {
            const int row = r0 % T, col = r1 % D; const float* xr = in[0] + (size_t)row * D; float ss = 0.f;
            for (int k = 0; k < D; ++k) ss += xr[k] * xr[k];
            const float v = xr[col] / sqrtf(ss / D + EPS) * in[1][col];
            if (!close_((float)((const h16*)(ws + WS_H))[(size_t)row * D + col], v)) chk_fail(ctl, 1);
        }
        {
            int n = r1 % INC, k = r2 % D;
            if (!close_((float)((const h16*)(ws + WS_WIN))[(size_t)n * D + k], in[2][(size_t)k * INC + n])) chk_fail(ctl, 2);
            n = r1 % 1024; k = r2 % 1024;
            if (!close_((float)((const h16*)(ws + WS_WGLU))[(size_t)n * 1024 + k], in[12][(size_t)k * 1024 + n])) chk_fail(ctl, 2);
            n = r1 % D; k = r2 % 512;
            if (!close_((float)((const h16*)(ws + WS_WUP))[(size_t)n * 1536 + k], in[14][(size_t)k * D + n])) chk_fail(ctl, 2);
            k = r2 % 1024;
            if (!close_((float)((const h16*)(ws + WS_WUP))[(size_t)n * 1536 + 512 + k], in[15][(size_t)k * D + n])) chk_fail(ctl, 2);
            k = r2 % D;
            if (!close_((float)((const h16*)(ws + WS_WOUT))[(size_t)n * D + k], in[16][(size_t)k * D + n])) chk_fail(ctl, 2);
        }
    }
    if (after == 1) {
        int n, k;
        const int e = r0 % NE; n = r1 % FF; k = r2 % D;
        if (!close_((float)((const h16*)(ws + WS_WGU))[((size_t)e * 1024 + n) * D + k], in[22][((size_t)e * D + k) * FF + n])) chk_fail(ctl, 2);
        if (!close_((float)((const h16*)(ws + WS_WGU))[((size_t)e * 1024 + 512 + n) * D + k], in[23][((size_t)e * D + k) * FF + n])) chk_fail(ctl, 2);
        n = r1 % D; k = r2 % FF;
        if (!close_((float)((const h16*)(ws + WS_WDN))[((size_t)e * D + n) * FF + k], in[24][((size_t)e * FF + k) * D + n])) chk_fail(ctl, 2);
    }
    if (after == 1) {
        const int row = r0 % T; int col = r1 % INC; if (tid & 1) col = COL_G + (r1 % 4096);
        float v = dot_hh((const h16*)(ws + WS_H) + (size_t)row * D, (const h16*)(ws + WS_WIN) + (size_t)col * D, D);
        if (col >= COL_G) v = 1.f / (1.f + expf(-(v + in[3][col - COL_G])));
        if (!close_((float)PROJ[(size_t)row * INC + col], v)) chk_fail(ctl, 3);
    }
    if (after == 2) {
        const int g = r0 % 3, t = r1 % T, hs = r2 % 8, dil = (g == 0) ? 1 : (g == 1 ? 4 : 16), hcol = (g * 8 + hs) * 64;
        const float slope = exp2f(-(float)(hs + 1));
        const h16* q = PROJ + (size_t)t * INC + hcol;
        float mx = -INFINITY;
        for (int j = 0; j <= 128; ++j) { const int tk = t - j * dil; if (tk < 0) break; const float sc = dot_hh(q, PROJ + (size_t)tk * INC + COL_K + hcol, 64) * 0.125f - slope * (float)(dil * j); mx = fmaxf(mx, sc); }
        float l = 0.f, o0 = 0.f, o1 = 0.f; const int d0 = r2 % 64, d1 = (r2 >> 8) % 64;
        for (int j = 0; j <= 128; ++j) { const int tk = t - j * dil; if (tk < 0) break; const float sc = dot_hh(q, PROJ + (size_t)tk * INC + COL_K + hcol, 64) * 0.125f - slope * (float)(dil * j);
            const float p = expf(sc - mx); l += p; o0 += p * (float)PROJ[(size_t)tk * INC + COL_V + hcol + d0]; o1 += p * (float)PROJ[(size_t)tk * INC + COL_V + hcol + d1]; }
        const h16* og = (const h16*)(ws + WS_OG) + ((size_t)g * T + t) * 512 + hs * 64;
        if (!close_((float)og[d0], o0 / l) || !close_((float)og[d1], o1 / l)) chk_fail(ctl, 4);
        if (!close_(((const float*)(ws + WS_LSE))[((size_t)g * T + t) * 8 + hs], mx + logf(l))) chk_fail(ctl, 5);
    }
    if (after == 3) {
        {
            const int t = r0 % T, hs = r1 % 8, d = r2 % 64; const float* LSE = (const float*)(ws + WS_LSE);
            float lse[3], m = -INFINITY; for (int g = 0; g < 3; ++g) { lse[g] = LSE[((size_t)g * T + t) * 8 + hs]; m = fmaxf(m, lse[g]); }
            float den = 0.f, num = 0.f; for (int g = 0; g < 3; ++g) { const float w = expf(lse[g] - m); den += w; num += w * (float)((const h16*)(ws + WS_OG))[((size_t)g * T + t) * 512 + hs * 64 + d]; }
            const h16 av = ((const h16*)(ws + WS_ACAT))[(size_t)t * 1536 + hs * 64 + d]; const float bv = num / den;
            if (__builtin_bit_cast(unsigned short, av) == 0xAAAAu) chk_fail(ctl, 6);
            else if (!(fabsf(bv) < 1e30f)) chk_fail(ctl, 7);
            else if (!close_((float)av, bv)) { chk_fail(ctl, 8); atomicAdd(ctl + CW_DBG + 1, 1u); if (t < 2048) atomicAdd(ctl + CW_DBG + 2, 1u); }
        }
        {
            const int wv = tid >> 6, p = tid & 63, gq = (wv * 9 + 3) % 64, gp = gq * 64 + p;
            const float are = in[4][gp], aim = in[5][gp], step = expf(in[6][gq]), mag = expf(are * step), ang = aim * step;
            const float br = mag * cosf(ang), bi = mag * sinf(ang), nr = br - 1.f, ni = bi, den = are * are + aim * aim;
            const float fr_ = (nr * are + ni * aim) / den, fi_ = (ni * are - nr * aim) / den;
            float bbr[16], bbi[16];
#pragma unroll
            for (int h = 0; h < 16; ++h) { const float b_r = in[7][(size_t)gp * 16 + h], b_i = in[8][(size_t)gp * 16 + h]; bbr[h] = fr_ * b_r - fi_ * b_i; bbi[h] = fr_ * b_i + fi_ * b_r; }
            float xr = 0.f, xi = 0.f; int ci = 0, tn = 5;
            for (int t = 0; t < T; ++t) {
                float bur = 0.f, bui = 0.f;
#pragma unroll
                for (int h = 0; h < 16; ++h) { const float u = (float)PROJ[(size_t)t * INC + COL_U + gq * 16 + h]; bur += bbr[h] * u; bui += bbi[h] * u; }
                const float nr2 = br * xr - bi * xi + bur, ni2 = br * xi + bi * xr + bui; xr = nr2; xi = ni2;
                if (t == tn) {
                    for (int h = 0; h < 16; ++h) {
                        float yv = in[9][((size_t)gq * 16 + h) * 64 + p] * xr - in[10][((size_t)gq * 16 + h) * 64 + p] * xi;
                        yv = wave_sum(yv);
                        yv += in[11][gq * 16 + h] * (float)PROJ[(size_t)t * INC + COL_U + gq * 16 + h];
                        const float z = 0.7978845608028654f * (yv + 0.044715f * yv * yv * yv), ge = 0.5f * yv * (1.f + tanhf(z));
                        if (p == 0 && !close_((float)((const h16*)(ws + WS_YG))[(size_t)t * SSMW + gq * 16 + h], ge)) chk_fail(ctl, 9);
                    }
                    ++ci; tn = (ci == 1) ? 64 + wv : (ci == 2 ? 1000 + 17 * wv : T - 1);
                }
            }
        }
    }
    if (after == 4) {
        const int row = r0 % T, c = r1 % 1024; const h16* yg = (const h16*)(ws + WS_YG) + (size_t)row * SSMW;
        const float v = dot_hh(yg, (const h16*)(ws + WS_WGLU) + (size_t)c * 1024, 1024) + in[13][c];
        if (!close_((float)((const h16*)(ws + WS_ACAT))[(size_t)row * 1536 + 512 + c], (float)yg[c] / (1.f + expf(-v)))) chk_fail(ctl, 10);
    }
    if (after == 5) {
        const int row = r0 % T, c = r1 % D; const h16* a = (const h16*)(ws + WS_ACAT) + (size_t)row * 1536; const h16* w = (const h16*)(ws + WS_WUP) + (size_t)c * 1536;
        const float va = dot_hh(a, w, 512), vs = dot_hh(a + 512, w + 512, 1024);
        const float ga = (float)PROJ[(size_t)row * INC + COL_G + c], gs = (float)PROJ[(size_t)row * INC + COL_G + D + c];
        if (!close_((float)((const h16*)(ws + WS_MERGED))[(size_t)row * D + c], ga * va + gs * vs)) chk_fail(ctl, 11);
    }
    if (after == 6) {
        const int row = r0 % T, c = r1 % D;
        const float v = in[0][(size_t)row * D + c] + dot_hh((const h16*)(ws + WS_MERGED) + (size_t)row * D, (const h16*)(ws + WS_WOUT) + (size_t)c * D, D);
        if (!close_(((const float*)(ws + WS_X1))[(size_t)row * D + c], v)) chk_fail(ctl, 12);
    }
}

__global__ void __launch_bounds__(NWAVES * 64, 2) fwd_kernel(Args args) {
    extern __shared__ __attribute__((aligned(16))) unsigned char lds_raw[];
    Frame F;
    F.lds = (LAS unsigned char*)lds_raw; F.ws = args.ws;
    F.tid = threadIdx.x; F.lane = F.tid & 63; F.wave = __builtin_amdgcn_readfirstlane(F.tid >> 6);
    F.G = gridDim.x; F.gw = blockIdx.x * NWAVES + F.wave; F.NGW = F.G * NWAVES;
    unsigned char* ws = args.ws;
    const float* const* in = args.in;
    volatile LAS unsigned* MISC = (volatile LAS unsigned*)(F.lds + MISC_OFF);
    for (int u = F.tid; u < (LDS_BYTES - LDSCTL_OFF) / 4; u += NWAVES * 64) ((LAS unsigned*)(F.lds + LDSCTL_OFF))[u] = 0u;
    __syncthreads();
    unsigned* ctl = (unsigned*)(ws + WS_CTL);
    XcdBarrier bar; bar.bar = ctl + CW_BAR; bar.x = 0; bar.st = nullptr;
    if (MK_N_LAUNCHES == 1) bar = xcd_barrier_post(ctl + CW_BAR, MISC + 8);
    const int lo = args.ph_lo, hi = args.ph_hi;
#ifndef PH_MASK
#define PH_MASK 0xFFF
#endif
#define IN(k) ((((PH_MASK) >> (k)) & 1) && lo <= (k) && (k) < hi)
#ifndef DUP_MASK
#define DUP_MASK 0
#endif
#define REPS(k) (1 + (((DUP_MASK) >> (k)) & 1))
#ifndef XBAR
#define XBAR 1
#endif
#ifndef TSA
#define TSA -1
#endif
#ifndef TSB
#define TSB -1
#endif
    unsigned long long* tsw = (unsigned long long*)(ws + WS_CTL + 40960);
#define STAMP(k) do { if (TSB >= 0 && blockIdx.x == 0 && tid == 0) tsw[k] = __builtin_amdgcn_s_memrealtime(); } while (0)
#define SEAM(k) do { if (IN(k) && IN((k) + 1)) for (int b_ = 0; b_ < XBAR; ++b_) xcd_barrier(bar); STAMP((k) + 1); } while (0)
    const int lane = F.lane, wave = F.wave, tid = F.tid;
    STAMP(0);
    if (DBGCHK && args.chk > 0) { if (blockIdx.x == 0) run_checks(args.chk - 1, in, ws, ctl, tid); return; }

    if (IN(0)) for (int rep_ = 0; rep_ < REPS(0); ++rep_) {
        LAS float* scr = (LAS float*)(F.lds + wave * 16384);
        const int gw = F.gw, NGW = F.NGW;
        constexpr int I_IN = (D / 64) * (INC / 32), I_GLU = (1024 / 64) * (1024 / 32), I_UA = (512 / 64) * (D / 32), I_US = (1024 / 64) * (D / 32), I_OUT = (D / 64) * (D / 32);
        constexpr int I_EG = (D / 64) * (FF / 32), I_ED = (FF / 64) * (D / 32);
        constexpr int NIT = I_IN + I_GLU + I_UA + I_US + I_OUT;
        for (int it = gw; it < NIT; it += NGW) {
            int rr = it;
            if (rr < I_IN) { p0_transpose_item(in[2], INC, (h16*)(ws + WS_WIN), D, 0, 0, scr, rr, lane); continue; } rr -= I_IN;
            if (rr < I_GLU) { p0_transpose_item(in[12], 1024, (h16*)(ws + WS_WGLU), 1024, 0, 0, scr, rr, lane); continue; } rr -= I_GLU;
            if (rr < I_UA) { p0_transpose_item(in[14], D, (h16*)(ws + WS_WUP), 1536, 0, 0, scr, rr, lane); continue; } rr -= I_UA;
            if (rr < I_US) { p0_transpose_item(in[15], D, (h16*)(ws + WS_WUP), 1536, 512, 0, scr, rr, lane); continue; } rr -= I_US;
            p0_transpose_item(in[16], D, (h16*)(ws + WS_WOUT), D, 0, 0, scr, rr, lane);
        }
        for (int m = gw; m < T; m += NGW) rms_row_to_h16(in[0] + (size_t)m * D, in[1], (h16*)(ws + WS_H) + (size_t)m * D, lane);
        {
            const int gt = blockIdx.x * (NWAVES * 64) + tid;
            if (gt < 4096) {
                const int g = gt >> 6, p = gt & 63;
                const float are = in[4][gt], aim = in[5][gt], step = expf(in[6][g]);
                const float mag = expf(are * step), ang = aim * step;
                float sn, cs; sincosf(ang, &sn, &cs);
                const float br = mag * cs, bi = mag * sn;
                float pr = br, pi = bi;
#pragma unroll
                for (int k = 0; k < 6; ++k) { const float nr2 = pr * pr - pi * pi, ni2 = 2.f * pr * pi; pr = nr2; pi = ni2; }
                ((f32x4*)(ws + WS_AB))[gt] = (f32x4){br, bi, pr, pi};
                const float nr = br - 1.0f, ni = bi, den = are * are + aim * aim;
                const float fr_ = (nr * are + ni * aim) / den, fi_ = (ni * are - nr * aim) / den;
                h16* BB = (h16*)(ws + WS_BB) + ((size_t)g * 128 + 2 * p) * 16;
                const float* bre = in[7] + (size_t)gt * 16; const float* bim = in[8] + (size_t)gt * 16;
#pragma unroll
                for (int h = 0; h < 16; ++h) { BB[h] = (h16)(fr_ * bre[h] - fi_ * bim[h]); BB[16 + h] = (h16)(fr_ * bim[h] + fi_ * bre[h]); }
                h16* CT = (h16*)(ws + WS_CT) + (size_t)g * 16 * 128 + 2 * p;
#pragma unroll
                for (int h = 0; h < 16; ++h) { CT[h * 128] = (h16)in[9][((size_t)g * 16 + h) * 64 + p]; CT[h * 128 + 1] = (h16)(-in[10][((size_t)g * 16 + h) * 64 + p]); }
            }
        }
        for (int i = blockIdx.x * (NWAVES * 64) + tid; i < D * 64; i += F.G * NWAVES * 64) {
            const int k = i >> 6, j = i & 63; const float gn = in[17][k];
            float v = 0.f; if (j < 32) v = in[20][k * 32 + j] * gn; else if (j < 36) v = in[18][k * 4 + (j - 32)] * gn;
            ((float*)(ws + WS_WR))[(((k >> 2) * 64 + j) << 2) + (k & 3)] = v;
        }
    }
    SEAM(0);

    if (TSB >= 0 && blockIdx.x == 0 && tid == 0) tsw[24] = __builtin_amdgcn_s_memtime() >> 5;
    if (IN(1)) for (int rep_ = 0; rep_ < REPS(1); ++rep_) {
        pg8::Gemm g{(const h16*)(ws + WS_H), (const h16*)(ws + WS_WIN), D, (size_t)pg8::HALF * D * 2};
        pg8::StaticOrder S; S.init(T, INC, D, F.G, (int)blockIdx.x);
        pg8::EpiProj E{(h16*)(ws + WS_PROJ), in[3]};
        pg8::ConvSide side; side.Wg = in[22]; side.Wu = in[23]; side.Wd = in[24]; side.ws = ws;
        side.scr = F.lds + SIDE_OFF + wave * SIDE_WAVE; side.it = F.gw; side.stride = F.NGW; side.lane = lane; side.pend = 0;
        pg8::gemm_phase<pg8::EpiProj, pg8::StaticOrder, true, false, pg8::ConvSide>(F.lds, g, S, E, side);
    }
    if (TSB >= 0 && blockIdx.x == 0 && tid == 0) { tsw[25] = __builtin_amdgcn_s_memtime() >> 5; tsw[26] = __builtin_amdgcn_s_memrealtime(); }
    SEAM(1);

    if (IN(2)) for (int rep_ = 0; rep_ < REPS(2); ++rep_) {
#ifndef NO_ATTN
        for (int it = blockIdx.x; it < 768; it += F.G) attn_pair(F, 2 * it);
#endif
#ifndef NO_SSM1
        ssm_wave<false>(F, in, F.lds + wave * 16384);
#endif
    }
    SEAM(2);

    if (IN(3)) for (int rep_ = 0; rep_ < REPS(3); ++rep_) {
        for (int i = blockIdx.x * (NWAVES * 64) + tid; i < T * 64; i += F.G * NWAVES * 64) {
            const int t = i >> 6, hsl = (i >> 3) & 7, c8 = i & 7;
            const float* LSE = (const float*)(ws + WS_LSE);
            const float l0 = LSE[((size_t)0 * T + t) * 8 + hsl], l1 = LSE[((size_t)1 * T + t) * 8 + hsl], l2 = LSE[((size_t)2 * T + t) * 8 + hsl];
            const float m = fmaxf(l0, fmaxf(l1, l2));
            float w0 = __expf(l0 - m), w1 = __expf(l1 - m), w2 = __expf(l2 - m); const float inv = 1.0f / (w0 + w1 + w2); w0 *= inv; w1 *= inv; w2 *= inv;
            const h16* OG = (const h16*)(ws + WS_OG) + (size_t)t * 512 + hsl * 64 + c8 * 8;
            const u32x4 a = *(const u32x4*)OG, b = *(const u32x4*)(OG + (size_t)T * 512), cc = *(const u32x4*)(OG + (size_t)2 * T * 512);
            u32x4 o;
#pragma unroll
            for (int e = 0; e < 4; ++e) {
                const h16x2 ha = pg8::as_h2(a[e]), hb = pg8::as_h2(b[e]), hc = pg8::as_h2(cc[e]);
                o[e] = pk2(w0 * (float)ha.x + w1 * (float)hb.x + w2 * (float)hc.x, w0 * (float)ha.y + w1 * (float)hb.y + w2 * (float)hc.y);
            }
            if (DBG & 1) o = (u32x4){0u, 0u, 0u, 0u};
            *(u32x4*)((h16*)(ws + WS_ACAT) + (size_t)t * 1536 + hsl * 64 + c8 * 8) = o;
        }
        ssm_wave<true>(F, in, F.lds + wave * 16384);
    }
    SEAM(3);

    if (IN(4)) for (int rep_ = 0; rep_ < REPS(4); ++rep_) {
        pg8::Gemm g{(const h16*)(ws + WS_YG), (const h16*)(ws + WS_WGLU), 1024, (size_t)pg8::HALF * 1024 * 2};
        pg8::StaticOrder S; S.init(T, 1024, 1024, F.G, (int)blockIdx.x);
        pg8::EpiGlu E{(const h16*)(ws + WS_YG), (h16*)(ws + WS_ACAT), in[13]};
        pg8::gemm_phase<pg8::EpiGlu, pg8::StaticOrder>(F.lds, g, S, E);
    }
    SEAM(4);

    if (IN(5)) for (int rep_ = 0; rep_ < REPS(5); ++rep_) {
        pg8::Gemm g{(const h16*)(ws + WS_ACAT), (const h16*)(ws + WS_WUP), 1536, (size_t)pg8::HALF * 1536 * 2};
        pg8::StaticOrder S; S.init(T, D, 1536, F.G, (int)blockIdx.x);
        pg8::EpiUp E{(const h16*)(ws + WS_PROJ), (h16*)(ws + WS_MERGED)};
        pg8::gemm_phase<pg8::EpiUp, pg8::StaticOrder>(F.lds, g, S, E);
    }
    SEAM(5);

    if (IN(6)) for (int rep_ = 0; rep_ < REPS(6); ++rep_) {
        pg8::Gemm g{(const h16*)(ws + WS_MERGED), (const h16*)(ws + WS_WOUT), D, (size_t)pg8::HALF * D * 2};
        pg8::StaticOrder S; S.init(T, D, D, F.G, (int)blockIdx.x);
        pg8::EpiOut E{in[0], (float*)(ws + WS_X1)};
        pg8::gemm_phase<pg8::EpiOut, pg8::StaticOrder>(F.lds, g, S, E);
    }
    SEAM(6);

    if (IN(7)) for (int rep_ = 0; rep_ < REPS(7); ++rep_) {
        const float* X1 = (const float*)(ws + WS_X1); const float* WR = (const float*)(ws + WS_WR);
        STAMP(16);
        LAS float* part = (LAS float*)F.lds;
        LAS f32x4* sinfo = (LAS f32x4*)(F.lds + 8 * 32 * 40 * 4);
        LAS float* red = (LAS float*)(F.lds + 41984);
        LAS float* xt = (LAS float*)(F.lds + 47104) + wave * (32 * 36);
        LAS float* wgs = (LAS float*)(F.lds + 83968) + wave * 1024;
        for (int tb = blockIdx.x; tb < T / 32; tb += F.G) {
            const int t0 = tb * 32, i = lane & 31, kk = lane >> 5, kbase = wave * 256;
            f32x16 ae = {0.f, 0.f, 0.f, 0.f, 0.f, 0.f, 0.f, 0.f, 0.f, 0.f, 0.f, 0.f, 0.f, 0.f, 0.f, 0.f};
            float ss = 0.f, g0 = 0.f, g1 = 0.f, g2 = 0.f, g3 = 0.f;
            const f32x4* wq = (const f32x4*)WR + (size_t)(kbase / 4 + kk) * 64 + i;
            { const f32x4* gsrc = (const f32x4*)WR + ((size_t)(kbase / 4 + lane) * 64 + 32);
#pragma unroll
              for (int g = 0; g < 4; ++g) *(LAS f32x4*)(wgs + lane * 16 + g * 4) = gsrc[g]; }
            const float* xsrc = X1 + (size_t)t0 * D + kbase + 4 * (lane & 7);
            f32x4 xr[4];
#pragma unroll
            for (int q = 0; q < 4; ++q) xr[q] = *(const f32x4*)(xsrc + (size_t)(8 * q + (lane >> 3)) * D);
#pragma unroll 1
            for (int sc_ = 0; sc_ < 8; ++sc_) {
                f32x4 we[4];
#pragma unroll
                for (int m = 0; m < 4; ++m) we[m] = wq[(size_t)(sc_ * 4 + m) * 128];
#pragma unroll
                for (int q = 0; q < 4; ++q) *(LAS f32x4*)(xt + (8 * q + (lane >> 3)) * 36 + 4 * (lane & 7)) = xr[q];
                if (sc_ < 7) {
#pragma unroll
                    for (int q = 0; q < 4; ++q) xr[q] = *(const f32x4*)(xsrc + (size_t)(8 * q + (lane >> 3)) * D + 32 * (sc_ + 1)); }
#pragma unroll
                for (int m = 0; m < 4; ++m) {
                    const f32x4 xv = *(const LAS f32x4*)(xt + i * 36 + 8 * m + 4 * kk);
                    const LAS f32x4* gw4 = (const LAS f32x4*)(wgs + (8 * sc_ + 2 * m + kk) * 16);
                    const f32x4 w0 = gw4[0], w1 = gw4[1], w2 = gw4[2], w3 = gw4[3];
                    ss += (xv.x * xv.x + xv.y * xv.y) + (xv.z * xv.z + xv.w * xv.w);
#pragma unroll
                    for (int e = 0; e < 4; ++e) {
                        ae = __builtin_amdgcn_mfma_f32_32x32x2f32(xv[e], we[m][e], ae, 0, 0, 0);
                        g0 += xv[e] * w0[e]; g1 += xv[e] * w1[e]; g2 += xv[e] * w2[e]; g3 += xv[e] * w3[e];
                    }
                }
            }
            ss += __shfl_xor(ss, 32); g0 += __shfl_xor(g0, 32); g1 += __shfl_xor(g1, 32); g2 += __shfl_xor(g2, 32); g3 += __shfl_xor(g3, 32);
            LAS float* pw = part + wave * (32 * 40);
#pragma unroll
            for (int q = 0; q < 16; ++q) { const int tr = (q & 3) + 8 * (q >> 2) + 4 * kk; pw[tr * 40 + i] = ae[q]; }
            if (kk == 0) { *(LAS f32x4*)(pw + i * 40 + 32) = (f32x4){g0, g1, g2, g3}; pw[i * 40 + 36] = ss; }
            __syncthreads();
            STAMP(17);
            int tq7 = tid; asm volatile("" : "+v"(tq7));
            for (int idx = tq7; idx < 32 * 37; idx += NWAVES * 64) { const int tk = idx / 37, j = idx - tk * 37; float a = 0.f;
#pragma unroll
                for (int w = 0; w < 8; ++w) a += part[w * (32 * 40) + tk * 40 + j];
                red[tk * 40 + j] = a; }
            __syncthreads();
            if (tid < 32) {
                const int t = t0 + tid; float lg[36];
#pragma unroll
                for (int j = 0; j < 36; ++j) lg[j] = red[tid * 40 + j];
                const float sq = red[tid * 40 + 36];
                const float rs = 1.0f / sqrtf(sq * (1.0f / D) + EPS);
                float gl[4]; int gi = 0; float gm;
#pragma unroll
                for (int j = 0; j < 4; ++j) gl[j] = lg[32 + j] * rs + in[19][j];
                gm = gl[0];
#pragma unroll
                for (int j = 1; j < 4; ++j) if (gl[j] > gm) { gm = gl[j]; gi = j; }
                float gsum = 0.f;
#pragma unroll
                for (int j = 0; j < 4; ++j) gsum += expf(gl[j] - gm);
                const float gp = 1.0f / gsum;
                float el[8];
#pragma unroll
                for (int j = 0; j < 8; ++j) { float v = 0.f;
#pragma unroll
                    for (int q = 0; q < 4; ++q) v = (gi == q) ? lg[q * 8 + j] : v;
                    el[j] = v * rs + in[21][gi * 8 + j]; }
                int j0 = 0; float v0 = el[0];
#pragma unroll
                for (int j = 1; j < 8; ++j) if (el[j] > v0) { v0 = el[j]; j0 = j; }
                int j1 = -1; float v1 = -INFINITY;
#pragma unroll
                for (int j = 0; j < 8; ++j) if (j != j0 && el[j] > v1) { v1 = el[j]; j1 = j; }
                const float e1 = expf(v1 - v0), w0 = gp / (1.0f + e1), w1 = gp * e1 / (1.0f + e1);
                const int ex0 = gi * 8 + j0, ex1 = gi * 8 + j1;
                const unsigned s0 = atomicAdd(ctl + CW_CNT + 64 * ex0, 1u), s1 = atomicAdd(ctl + CW_CNT + 64 * ex1, 1u);
                int row0 = ex0 * CAP + (int)s0, row1 = ex1 * CAP + (int)s1;
                if (s0 >= (unsigned)CAP) { const unsigned ix = atomicAdd(ctl + CW_OVF, 1u); ((int4*)(ws + WS_OVF))[ix] = make_int4(t, ex0, 0, 0); row0 = -1; }
                if (s1 >= (unsigned)CAP) { const unsigned ix = atomicAdd(ctl + CW_OVF, 1u); ((int4*)(ws + WS_OVF))[ix] = make_int4(t, ex1, 1, 0); row1 = -1; }
                ((int2*)(ws + WS_TOKROW))[t] = make_int2(row0, row1);
                ((f32x4*)(ws + WS_ROUTF))[t] = (f32x4){w0, w1, rs, 0.f};
                sinfo[tid] = (f32x4){__int_as_float(row0), __int_as_float(row1), rs, 0.f};
            }
            __syncthreads();
            STAMP(18);
#pragma unroll 4
            for (int q = 0; q < 4; ++q) {
                const int tl_ = wave * 4 + q; const f32x4 si = sinfo[tl_]; const int row0 = __float_as_int(si.x), row1 = __float_as_int(si.y); const float rs = si.z;
                const f32x4* xr2 = (const f32x4*)(X1 + (size_t)(t0 + tl_) * D) + lane; const f32x4* gr = (const f32x4*)in[17] + lane;
                u32x2* o0 = (u32x2*)((h16*)(ws + WS_XS) + (size_t)(row0 < 0 ? 0 : row0) * D) + lane; u32x2* o1 = (u32x2*)((h16*)(ws + WS_XS) + (size_t)(row1 < 0 ? 0 : row1) * D) + lane;
                f32x4 vv[8];
#pragma unroll
                for (int j = 0; j < 8; ++j) vv[j] = xr2[64 * j];
#pragma unroll
                for (int j = 0; j < 8; ++j) { const f32x4 v = vv[j], gn = gr[64 * j]; u32x2 w; w.x = pk2(v.x * rs * gn.x, v.y * rs * gn.y); w.y = pk2(v.z * rs * gn.z, v.w * rs * gn.w);
                    if (row0 >= 0) o0[64 * j] = w; if (row1 >= 0) o1[64 * j] = w; }
            }
            __syncthreads();
            STAMP(19);
        }
    }
    if (IN(7) && IN(9)) xcd_barrier(bar);
    STAMP(8); STAMP(9);


    LAS int* tlist = (LAS int*)(F.lds + LDSCTL_OFF + 1024);
    if (IN(9) || IN(10)) {
        int tq = tid; asm volatile("" : "+v"(tq));
        if (tq < NE) tlist[128 + tq] = (int)xb_ld(ctl + CW_CNT + 64 * tq);
        __syncthreads();
        if (tid == 0) {
            int nt_ = 0;
            for (int x = 0; x < 8; ++x) { tlist[x] = nt_;
                for (int pass = 0; pass < 2; ++pass)
                    for (int e = x; e < NE; e += 8) { int c = tlist[128 + e]; c = c > CAP ? CAP : c;
                        for (int j = 0; j < CAPT; ++j) { const int rows = c - 256 * j; const bool full = rows > 128, half = rows > 0 && rows <= 128;
                            if (pass == 0 ? full : half) { tlist[16 + nt_] = (e * CAPT + j) | (pass << 16); ++nt_; } } }
                tlist[8 + x] = nt_ - tlist[x]; }
        }
        __syncthreads();
    }
    STAMP(20);
    if (IN(9)) for (int rep_ = 0; rep_ < REPS(9); ++rep_) {
        {
            const int novf = (int)xb_ld(ctl + CW_OVF);
            int tv = tid; asm volatile("" : "+v"(tv));
            LAS float* hrow = (LAS float*)F.lds; LAS float* hidv = hrow + D;
            for (int ix = blockIdx.x; ix < novf && rep_ == 0; ix += F.G) {
                const int4 en = ((const int4*)(ws + WS_OVF))[ix]; const f32x4 rf = ((const f32x4*)(ws + WS_ROUTF))[en.x];
                const float* xr = (const float*)(ws + WS_X1) + (size_t)en.x * D;
                for (int k = tv; k < D; k += NWAVES * 64) hrow[k] = (float)(h16)(xr[k] * rf.z * in[17][k]);
                __syncthreads();
                { const h16* wg = (const h16*)(ws + WS_WGU) + ((size_t)en.y * 1024 + tv) * D; const h16* wu = wg + (size_t)512 * D; float ga = 0.f, up = 0.f;
                  for (int k = 0; k < D; ++k) { ga += hrow[k] * (float)wg[k]; up += hrow[k] * (float)wu[k]; }
                  hidv[tv] = (float)(h16)(ga * pg8::sigmoidf_(ga) * up); }
                __syncthreads();
                const float wk = en.z ? rf.y : rf.x;
                for (int c = tv; c < D; c += NWAVES * 64) { const h16* wd = (const h16*)(ws + WS_WDN) + ((size_t)en.y * D + c) * FF; float y = 0.f;
                    for (int k = 0; k < FF; ++k) y += hidv[k] * (float)wd[k];
                    atomicAdd((float*)(ws + WS_X1) + (size_t)en.x * D + c, wk * (float)(h16)y); }
                __syncthreads();
            }
        }
        STAMP(21);
        pg8::Gemm g{(const h16*)(ws + WS_XS), (const h16*)(ws + WS_WGU), D, (size_t)512 * D * 2};
        pg8::ExpertOrder S{tlist, 4, F.G, (int)blockIdx.x, (size_t)1024 * D * 2, (size_t)pg8::HALF * D * 2};
        pg8::EpiGateUp E{(h16*)(ws + WS_HID)};
        pg8::gemm_phase<pg8::EpiGateUp, pg8::ExpertOrder, true, true>(F.lds, g, S, E);
        STAMP(22);
    }
    SEAM(9);

    if (IN(10)) for (int rep_ = 0; rep_ < REPS(10); ++rep_) {
        pg8::Gemm g{(const h16*)(ws + WS_HID), (const h16*)(ws + WS_WDN), FF, (size_t)pg8::HALF * FF * 2};
        pg8::ExpertOrder S{tlist, 8, F.G, (int)blockIdx.x, (size_t)D * FF * 2, (size_t)pg8::BM * FF * 2};
        pg8::EpiDown E{(h16*)(ws + WS_Y)};
        pg8::gemm_phase<pg8::EpiDown, pg8::ExpertOrder, true, true>(F.lds, g, S, E);
    }
    SEAM(10);

    if (TSB >= 0) { xcd_barrier(bar); }
    if (IN(11)) for (int rep_ = 0; rep_ < REPS(11); ++rep_) {
        const float* X1 = (const float*)(ws + WS_X1); const h16* Y = (const h16*)(ws + WS_Y);
        for (int t = F.gw; t < T; t += F.NGW) {
            const int2 tr = ((const int2*)(ws + WS_TOKROW))[t]; const f32x4 rf = ((const f32x4*)(ws + WS_ROUTF))[t];
            const f32x4* xr = (const f32x4*)(X1 + (size_t)t * D) + lane;
            const u32x2* y0 = (const u32x2*)(Y + (size_t)(tr.x < 0 ? 0 : tr.x) * D) + lane; const u32x2* y1 = (const u32x2*)(Y + (size_t)(tr.y < 0 ? 0 : tr.y) * D) + lane;
            const float wa = tr.x < 0 ? 0.f : rf.x, wb = tr.y < 0 ? 0.f : rf.y;
            f32x4 v[8]; float s = 0.f;
#pragma unroll
            for (int j = 0; j < 8; ++j) { const f32x4 a = pg8::h4_to_f4(y0[64 * j]), b = pg8::h4_to_f4(y1[64 * j]); v[j] = (DBG & 4) ? xr[64 * j] : xr[64 * j] + wa * a + wb * b;
                s += (v[j].x * v[j].x + v[j].y * v[j].y) + (v[j].z * v[j].z + v[j].w * v[j].w); }
            const float r = 1.0f / sqrtf(wave_sum(s) * (1.0f / D) + EPS);
            const f32x4* gr = (const f32x4*)in[25] + lane; f32x4* orow = (f32x4*)(args.out + (size_t)t * D) + lane;
#pragma unroll
            for (int j = 0; j < 8; ++j) orow[64 * j] = v[j] * r * gr[64 * j];
            if (TSB >= 0) {
                const float ta = (TSA >= 0) ? (float)(tsw[(TSA >= 0 ? TSA : 0) + 1] - tsw[TSA >= 0 ? TSA : 0]) * 0.01f : 0.f, tb = (float)(tsw[TSB + 1] - tsw[TSB]) * 0.01f;
                const float amp = sqrtf(ta * 1e-6f) * ((lane & 1) ? 1.f : -1.f);
#pragma unroll
                for (int j = 0; j < 8; ++j) { f32x4 o = v[j] * r * gr[64 * j] + amp; if (TSB >= 0 && t == 0 && lane == 0 && j == 0) o.x += 1.0f + tb * 0.02f; orow[64 * j] = o; }
            }
            if (DBGCHK) {
                const unsigned dv = xb_ld(ctl + CW_DBG); const int code = dv ? 100 - (int)dv : 0;
                const float tab[13] = {1.f, 0.f, 0.5f, 2.f, 3.f, 4.f, 6.f, 10.f, 16.f, 30.f, 60.f, 120.f, 250.f};
                float sc = 1.f;
#pragma unroll
                for (int q = 0; q < 13; ++q) sc = (code == q) ? tab[q] : sc;
                if (code == 8) sc = 2.0f + 10.0f * (float)xb_ld(ctl + CW_DBG + 1) / 512.0f + 100.0f * (float)xb_ld(ctl + CW_DBG + 2) / 512.0f;
                const f32x4* x0 = (const f32x4*)(in[0] + (size_t)t * D) + lane; f32x4 xv[8]; float s2 = 0.f;
#pragma unroll
                for (int j = 0; j < 8; ++j) { xv[j] = x0[64 * j]; s2 += (xv[j].x * xv[j].x + xv[j].y * xv[j].y) + (xv[j].z * xv[j].z + xv[j].w * xv[j].w); }
                const float r2 = 1.0f / sqrtf(wave_sum(s2) * (1.0f / D) + EPS);
#pragma unroll
                for (int j = 0; j < 8; ++j) orow[64 * j] = xv[j] * (r2 * sc) * gr[64 * j];
            }
        }
    }
#undef IN
#undef SEAM
}

extern "C" void kernel_launch(void* const* d_in, const int* in_sizes, int n_in, void* d_out, int out_size, void* d_ws, size_t ws_size, hipStream_t stream) {
    static int grid = 0;
    if (grid == 0) {
        if (n_in != 26 || in_sizes[0] != T * D || out_size != T * D || ws_size < WS_END) { fprintf(stderr, "kernel_launch: unexpected shapes (n_in %d, in0 %d, out %d, ws %zu); nothing launched\n", n_in, n_in > 0 ? in_sizes[0] : -1, out_size, ws_size); grid = -1; return; }
        int dev = 0, cus = 0, per_cu = 0;
        if (hipGetDevice(&dev) != hipSuccess || hipDeviceGetAttribute(&cus, hipDeviceAttributeMultiprocessorCount, dev) != hipSuccess) { fprintf(stderr, "kernel_launch: device query failed\n"); grid = -1; return; }
        if (hipFuncSetAttribute((const void*)fwd_kernel, hipFuncAttributeMaxDynamicSharedMemorySize, LDS_BYTES) != hipSuccess) { fprintf(stderr, "kernel_launch: hipFuncSetAttribute failed\n"); grid = -1; return; }
        if (hipOccupancyMaxActiveBlocksPerMultiprocessor(&per_cu, (const void*)fwd_kernel, NWAVES * 64, LDS_BYTES) != hipSuccess || per_cu < 1) { fprintf(stderr, "kernel_launch: occupancy query reports %d workgroups per CU\n", per_cu); per_cu = 1; }
        (void)hipGetLastError();
        grid = cus;
    }
    if (grid < 0) return;
    if (hipMemsetAsync((char*)d_ws + WS_CTL, 0, CTL_ZERO_BYTES, stream) != hipSuccess) { fprintf(stderr, "kernel_launch: hipMemsetAsync failed\n"); return; }
    Args a{};
    for (int i = 0; i < 26; ++i) a.in[i] = (const float*)d_in[i];
    a.out = (float*)d_out; a.ws = (unsigned char*)d_ws;
    for (int li = 0; li < MK_N_LAUNCHES; ++li) {
        if (MK_N_LAUNCHES == 1) { a.ph_lo = 0; a.ph_hi = 12; } else { a.ph_lo = li; a.ph_hi = li + 1; }
        hipLaunchKernelGGL(fwd_kernel, dim3(grid), dim3(NWAVES * 64), LDS_BYTES, stream, a);
        const hipError_t le = hipPeekAtLastError();
        if (le != hipSuccess) { fprintf(stderr, "kernel_launch: launch %d failed: %s\n", li, hipGetErrorName(le)); break; }
        if (DBGCHK && MK_N_LAUNCHES > 1 && li <= 6) { Args c = a; c.ph_lo = 0; c.ph_hi = 0; c.chk = li + 1; hipLaunchKernelGGL(fwd_kernel, dim3(8), dim3(NWAVES * 64), LDS_BYTES, stream, c); }
    }
}
```

```cpp
#include <hip/hip_runtime.h>
#include <cstdio>
#include <cstdint>

#ifndef MK_N_LAUNCHES
#define MK_N_LAUNCHES 1
#endif

#ifndef DBG
#define DBG 0
#endif
#define LAS __attribute__((address_space(3)))
#define GAS __attribute__((address_space(1)))
typedef _Float16 h16;
typedef _Float16 h16x8 __attribute__((ext_vector_type(8)));
typedef _Float16 h16x4 __attribute__((ext_vector_type(4)));
typedef _Float16 h16x2 __attribute__((ext_vector_type(2)));
typedef float f32x2 __attribute__((ext_vector_type(2)));
typedef float f32x4 __attribute__((ext_vector_type(4)));
typedef float f32x16 __attribute__((ext_vector_type(16)));
typedef unsigned u32x2 __attribute__((ext_vector_type(2)));
typedef unsigned u32x4 __attribute__((ext_vector_type(4)));
typedef short s16x4 __attribute__((ext_vector_type(4)));

constexpr int T = 8192, D = 2048;
constexpr int QKV = 1536, SSMW = 1024, INC = 9728;
constexpr int COL_K = 1536, COL_V = 3072, COL_U = 4608, COL_G = 5632;
constexpr int NE = 32, FF = 512;
constexpr float EPS = 1e-6f;
constexpr float LOG2E = 1.4426950408889634f, LN2 = 0.6931471805599453f;

constexpr size_t MiB = 1u << 20;
constexpr size_t WS_CTL = 0, CTL_ZERO_BYTES = 64 * 1024;
constexpr size_t WS_AB = 1 * MiB;
constexpr size_t WS_BB = WS_AB + 256 * 1024;
constexpr size_t WS_CT = WS_BB + 256 * 1024;
constexpr size_t WS_LSE = 2 * MiB;
constexpr size_t WS_ROUTI = 3 * MiB;
constexpr size_t WS_ROUTF = WS_ROUTI + 128 * 1024;
constexpr size_t WS_TOKROW = WS_ROUTF + 128 * 1024;
constexpr size_t WS_TILEE = WS_TOKROW + 64 * 1024;
constexpr size_t WS_WR = 4 * MiB;
constexpr size_t WS_S = 8 * MiB;
constexpr size_t WS_WIN = 12 * MiB;
constexpr size_t WS_H = 50 * MiB;
constexpr size_t WS_X1 = 12 * MiB;
constexpr size_t WS_WGLU = 82 * MiB;
constexpr size_t WS_WUP = 84 * MiB;
constexpr size_t WS_WOUT = 90 * MiB;
constexpr size_t WS_WGU = 98 * MiB;
constexpr size_t WS_WDN = 226 * MiB;
constexpr size_t WS_PROJ = 290 * MiB;
constexpr size_t WS_OG = 442 * MiB;
constexpr size_t WS_YG = 466 * MiB;
constexpr size_t WS_ACAT = 482 * MiB;
constexpr size_t WS_MERGED = 442 * MiB;
constexpr size_t WS_XS = 290 * MiB;
constexpr size_t WS_HID = 386 * MiB;
constexpr size_t WS_Y = 410 * MiB;
constexpr size_t WS_END = 506 * MiB;
constexpr int MAXTILES = 96;
constexpr int CAP = 768, CAPT = CAP / 256;
constexpr size_t WS_OVF = WS_TILEE + 4096;
constexpr int MAXOVF = 2 * T;
constexpr int CW_BAR = 4096;
constexpr int CW_CNT = 8192;
constexpr int CW_OVF = 8192 + 64 * 32;

namespace pg8 {
constexpr int BM = 256, BK = 64, HALF = 128, HTB = HALF * BK * 2, STAGE_BYTES = 8 * HTB, NXCD = 8, WGM = 8;
__host__ __device__ __forceinline__ int lds_byte(int r, int c) { const int st = (r >> 4) * 2 + (c >> 5), rr = r & 15, cc = c & 31, ob = rr * 64 + cc * 2; return st * 1024 + (ob ^ (((ob >> 9) & 1) << 5)); }
__host__ __device__ __forceinline__ void stage_rc(int b, int& R, int& C) { const int st = b / 1024, sb = b % 1024, swz = sb ^ (((sb >> 9) & 1) << 5); R = (st >> 1) * 16 + swz / 64; C = (st & 1) * 32 + (swz % 64) / 2; }
__host__ __device__ __forceinline__ int perm32(int rho) { const int n = rho >> 4, i = rho & 15; return 8 * (i >> 2) + 4 * n + (i & 3); }

struct Unit { int pm, pn; size_t boff; int half; };
struct Gemm { const h16* A; const h16* Bt; int K; size_t b_hstep; };

struct StaticOrder {
    int nM, nN, nwg, G, c, K;
    __device__ void init(int M, int N, int K_, int G_, int c_) { nM = M / BM; nN = N / BM; nwg = nM * nN; G = G_; c = c_; K = K_; }
    __device__ bool next(int i, Unit& u) const {
        const long L = (long)i * G + c; if (L >= nwg) return false;
        int wgid = (int)L; { const int q = nwg / NXCD, r = nwg % NXCD, xcd = wgid % NXCD, off = wgid / NXCD; wgid = (xcd < r ? xcd * (q + 1) : r * (q + 1) + (xcd - r) * q) + off; }
        const int nig = WGM * nN, gid = wgid / nig, fm = gid * WGM, gsz = (nM - fm) < WGM ? (nM - fm) : WGM;
        u.pm = fm + ((wgid % nig) % gsz); u.pn = (wgid % nig) / gsz; u.boff = (size_t)u.pn * BM * K * 2; u.half = 0; return true;
    }
};
struct ExpertOrder {
    const LAS int* tl; int NT, G, c; size_t e_bytes, pn_bytes;
    __device__ bool next(int i, Unit& u) const {
        const int x = c & 7, off = i * (G >> 3) + (c >> 3), ti = off / NT; if (ti >= tl[8 + x]) return false;
        const int ent = tl[16 + tl[x] + ti]; u.pm = ent & 0xffff; u.half = ent >> 16; u.pn = off % NT;
        const int e = u.pm / CAPT; u.boff = (size_t)e * e_bytes + (size_t)u.pn * pn_bytes; return true;
    }
};
__device__ __forceinline__ unsigned pk2(float lo, float hi) { f32x2 v = {lo, hi}; h16x2 h = __builtin_convertvector(v, h16x2); return __builtin_bit_cast(unsigned, h); }
__device__ __forceinline__ float sigmoidf_(float x) { return __builtin_amdgcn_rcpf(1.0f + __builtin_amdgcn_exp2f(-x * LOG2E)); }
__device__ __forceinline__ h16x2 as_h2(unsigned u) { return __builtin_bit_cast(h16x2, u); }
__device__ __forceinline__ f32x4 h4_to_f4(u32x2 w) { const h16x2 a = as_h2(w.x), b = as_h2(w.y); return (f32x4){(float)a.x, (float)a.y, (float)b.x, (float)b.y}; }

typedef f32x4 Acc[2][2][4][2];

struct EpiProj {
    static constexpr bool PERM = true; static constexpr int HOOK_T = -1;
    h16* O; const float* bgate;
    __device__ __forceinline__ void mid(Acc&, const Unit&, int, int, int, int) const {}
    __device__ __forceinline__ void operator()(const Acc& acc, const Unit& u, int wr, int wc, int fr, int fq) const {
        const int row0 = u.pm * BM + wr * 64 + fr, col0 = u.pn * BM + wc * 32 + 8 * fq;
        const bool isg = __builtin_amdgcn_readfirstlane(u.pn) >= COL_G / BM;
        if (isg) {
            f32x4 bb[2][2];
#pragma unroll
            for (int bj = 0; bj < 2; ++bj) { bb[bj][0] = *(const f32x4*)(bgate + col0 - COL_G + bj * HALF); bb[bj][1] = *(const f32x4*)(bgate + col0 - COL_G + bj * HALF + 4); }
#pragma unroll
            for (int ai = 0; ai < 2; ++ai)
#pragma unroll
                for (int m = 0; m < 4; ++m)
#pragma unroll
                    for (int bj = 0; bj < 2; ++bj) {
                        f32x4 v0 = acc[ai][bj][m][0] + bb[bj][0], v1 = acc[ai][bj][m][1] + bb[bj][1];
#pragma unroll
                        for (int e = 0; e < 4; ++e) { v0[e] = sigmoidf_(v0[e]); v1[e] = sigmoidf_(v1[e]); }
                        u32x4 w; w.x = pk2(v0[0], v0[1]); w.y = pk2(v0[2], v0[3]); w.z = pk2(v1[0], v1[1]); w.w = pk2(v1[2], v1[3]);
                        *(u32x4*)(O + (size_t)(row0 + ai * HALF + m * 16) * INC + col0 + bj * HALF) = w; }
        } else {
#pragma unroll
            for (int ai = 0; ai < 2; ++ai)
#pragma unroll
                for (int m = 0; m < 4; ++m)
#pragma unroll
                    for (int bj = 0; bj < 2; ++bj) {
                        const f32x4 v0 = acc[ai][bj][m][0], v1 = acc[ai][bj][m][1];
                        u32x4 w; w.x = pk2(v0[0], v0[1]); w.y = pk2(v0[2], v0[3]); w.z = pk2(v1[0], v1[1]); w.w = pk2(v1[2], v1[3]);
                        *(u32x4*)(O + (size_t)(row0 + ai * HALF + m * 16) * INC + col0 + bj * HALF) = w; }
        }
    }
};
struct EpiGlu {
    static constexpr bool PERM = true; static constexpr int HOOK_T = -1;
    const h16* YG; h16* ACAT; const float* bglu;
    __device__ __forceinline__ void mid(Acc&, const Unit&, int, int, int, int) const {}
    __device__ __forceinline__ void operator()(const Acc& acc, const Unit& u, int wr, int wc, int fr, int fq) const {
        const int row0 = u.pm * BM + wr * 64 + fr, col0 = u.pn * BM + wc * 32 + 8 * fq;
        f32x4 bb[2][2]; u32x4 yw[4][2], yn[4][2];
#pragma unroll
        for (int bj = 0; bj < 2; ++bj) { bb[bj][0] = *(const f32x4*)(bglu + col0 + bj * HALF); bb[bj][1] = *(const f32x4*)(bglu + col0 + bj * HALF + 4); }
#pragma unroll
        for (int m = 0; m < 4; ++m)
#pragma unroll
            for (int bj = 0; bj < 2; ++bj) yw[m][bj] = *(const u32x4*)(YG + (size_t)(row0 + m * 16) * SSMW + col0 + bj * HALF);
#pragma unroll
        for (int ai = 0; ai < 2; ++ai) {
            u32x4 wv[4][2];
#pragma unroll
            for (int m = 0; m < 4; ++m)
#pragma unroll
                for (int bj = 0; bj < 2; ++bj) {
                    const u32x4 q = yw[m][bj];
                    const f32x4 y0 = h4_to_f4((u32x2){q.x, q.y}), y1 = h4_to_f4((u32x2){q.z, q.w});
                    f32x4 v0 = acc[ai][bj][m][0] + bb[bj][0], v1 = acc[ai][bj][m][1] + bb[bj][1];
#pragma unroll
                    for (int e = 0; e < 4; ++e) { v0[e] = y0[e] * sigmoidf_(v0[e]); v1[e] = y1[e] * sigmoidf_(v1[e]); }
                    u32x4 w; w.x = pk2(v0[0], v0[1]); w.y = pk2(v0[2], v0[3]); w.z = pk2(v1[0], v1[1]); w.w = pk2(v1[2], v1[3]);
                    if (DBG & 2) w = (u32x4){0u, 0u, 0u, 0u};
                    wv[m][bj] = w; }
            if (ai == 0) {
#pragma unroll
                for (int m = 0; m < 4; ++m)
#pragma unroll
                    for (int bj = 0; bj < 2; ++bj) yn[m][bj] = *(const u32x4*)(YG + (size_t)(row0 + HALF + m * 16) * SSMW + col0 + bj * HALF);
            }
#pragma unroll
            for (int m = 0; m < 4; ++m)
#pragma unroll
                for (int bj = 0; bj < 2; ++bj) *(u32x4*)(ACAT + (size_t)(row0 + ai * HALF + m * 16) * 1536 + 512 + col0 + bj * HALF) = wv[m][bj];
#pragma unroll
            for (int m = 0; m < 4; ++m)
#pragma unroll
                for (int bj = 0; bj < 2; ++bj) yw[m][bj] = yn[m][bj];
        }
    }
};
struct EpiUp {
    static constexpr bool PERM = true; static constexpr int HOOK_T = 8;
    const h16* PROJ; h16* O;
    __device__ __forceinline__ void mid(Acc& acc, const Unit& u, int wr, int wc, int fr, int fq) const {
        int row0 = u.pm * BM + wr * 64 + fr, col0 = u.pn * BM + wc * 32 + 8 * fq;
        asm volatile("" : "+v"(row0), "+v"(col0));
#pragma unroll
        for (int ai = 0; ai < 2; ++ai) {
            u32x4 ga[4][2], gs[4][2];
#pragma unroll
            for (int m = 0; m < 4; ++m)
#pragma unroll
                for (int bj = 0; bj < 2; ++bj) { const h16* gp = PROJ + (size_t)(row0 + ai * HALF + m * 16) * INC + COL_G + col0 + bj * HALF; ga[m][bj] = *(const u32x4*)gp; gs[m][bj] = *(const u32x4*)(gp + D); }
#pragma unroll
            for (int m = 0; m < 4; ++m)
#pragma unroll
                for (int bj = 0; bj < 2; ++bj) {
                    const u32x4 a = ga[m][bj], q = gs[m][bj];
                    const f32x4 a0 = h4_to_f4((u32x2){a.x, a.y}), a1 = h4_to_f4((u32x2){a.z, a.w}), s0 = h4_to_f4((u32x2){q.x, q.y}), s1 = h4_to_f4((u32x2){q.z, q.w});
#pragma unroll
                    for (int e = 0; e < 4; ++e) { acc[ai][bj][m][0][e] *= a0[e] * __builtin_amdgcn_rcpf(s0[e]); acc[ai][bj][m][1][e] *= a1[e] * __builtin_amdgcn_rcpf(s1[e]); }
                }
            asm volatile("" ::: "memory");
        }
    }
    __device__ __forceinline__ void operator()(const Acc& acc, const Unit& u, int wr, int wc, int fr, int fq) const {
        const int row0 = u.pm * BM + wr * 64 + fr, col0 = u.pn * BM + wc * 32 + 8 * fq;
        u32x4 gs[4][2], gn[4][2];
#pragma unroll
        for (int m = 0; m < 4; ++m)
#pragma unroll
            for (int bj = 0; bj < 2; ++bj) gs[m][bj] = *(const u32x4*)(PROJ + (size_t)(row0 + m * 16) * INC + COL_G + D + col0 + bj * HALF);
#pragma unroll
        for (int ai = 0; ai < 2; ++ai) {
            u32x4 wv[4][2];
#pragma unroll
            for (int m = 0; m < 4; ++m)
#pragma unroll
                for (int bj = 0; bj < 2; ++bj) {
                    const u32x4 q = gs[m][bj];
                    const f32x4 s0 = h4_to_f4((u32x2){q.x, q.y}), s1 = h4_to_f4((u32x2){q.z, q.w});
                    const f32x4 v0 = acc[ai][bj][m][0] * s0, v1 = acc[ai][bj][m][1] * s1;
                    u32x4 w; w.x = pk2(v0[0], v0[1]); w.y = pk2(v0[2], v0[3]); w.z = pk2(v1[0], v1[1]); w.w = pk2(v1[2], v1[3]);
                    wv[m][bj] = w; }
            if (ai == 0) {
#pragma unroll
                for (int m = 0; m < 4; ++m)
#pragma unroll
                    for (int bj = 0; bj < 2; ++bj) gn[m][bj] = *(const u32x4*)(PROJ + (size_t)(row0 + HALF + m * 16) * INC + COL_G + D + col0 + bj * HALF);
            }
#pragma unroll
            for (int m = 0; m < 4; ++m)
#pragma unroll
                for (int bj = 0; bj < 2; ++bj) *(u32x4*)(O + (size_t)(row0 + ai * HALF + m * 16) * D + col0 + bj * HALF) = wv[m][bj];
#pragma unroll
            for (int m = 0; m < 4; ++m)
#pragma unroll
                for (int bj = 0; bj < 2; ++bj) gs[m][bj] = gn[m][bj];
        }
    }
};
struct EpiOut {
    static constexpr bool PERM = false; static constexpr int HOOK_T = -1;
    const float* X; float* X1;
    __device__ __forceinline__ void mid(Acc&, const Unit&, int, int, int, int) const {}
    __device__ __forceinline__ void operator()(const Acc& acc, const Unit& u, int wr, int wc, int fr, int fq) const {
        const int row0 = u.pm * BM + wr * 64 + fr, col0 = u.pn * BM + wc * 32 + 4 * fq;
        f32x4 cur[2][2], nxt[2][2];
#pragma unroll
        for (int bj = 0; bj < 2; ++bj)
#pragma unroll
            for (int n = 0; n < 2; ++n) cur[bj][n] = *(const f32x4*)(X + (size_t)row0 * D + col0 + bj * HALF + n * 16);
#pragma unroll
        for (int gi = 0; gi < 8; ++gi) {
            const int ai = gi >> 2, m = gi & 3; const size_t off = (size_t)(row0 + ai * HALF + m * 16) * D + col0;
            if (gi < 7) { const int ai2 = (gi + 1) >> 2, m2 = (gi + 1) & 3; const size_t off2 = (size_t)(row0 + ai2 * HALF + m2 * 16) * D + col0;
#pragma unroll
                for (int bj = 0; bj < 2; ++bj)
#pragma unroll
                    for (int n = 0; n < 2; ++n) nxt[bj][n] = *(const f32x4*)(X + off2 + bj * HALF + n * 16); }
#pragma unroll
            for (int bj = 0; bj < 2; ++bj)
#pragma unroll
                for (int n = 0; n < 2; ++n) *(f32x4*)(X1 + off + bj * HALF + n * 16) = cur[bj][n] + acc[ai][bj][m][n];
#pragma unroll
            for (int bj = 0; bj < 2; ++bj)
#pragma unroll
                for (int n = 0; n < 2; ++n) cur[bj][n] = nxt[bj][n];
        }
    }
};
struct EpiGateUp {
    static constexpr bool PERM = true; static constexpr int HOOK_T = -1;
    h16* HID;
    __device__ __forceinline__ void mid(Acc&, const Unit&, int, int, int, int) const {}
    __device__ __forceinline__ void operator()(const Acc& acc, const Unit& u, int wr, int wc, int fr, int fq) const {
        const int row0 = u.pm * BM + wr * 64 + fr, col0 = u.pn * HALF + wc * 32 + 8 * fq;
#pragma unroll
        for (int ai = 0; ai < 2; ++ai) if (ai == 0 || !u.half)
#pragma unroll
            for (int m = 0; m < 4; ++m) {
                f32x4 v[2];
#pragma unroll
                for (int n = 0; n < 2; ++n)
#pragma unroll
                    for (int e = 0; e < 4; ++e) { const float g = acc[ai][0][m][n][e]; v[n][e] = g * sigmoidf_(g) * acc[ai][1][m][n][e]; }
                u32x4 w; w.x = pk2(v[0][0], v[0][1]); w.y = pk2(v[0][2], v[0][3]); w.z = pk2(v[1][0], v[1][1]); w.w = pk2(v[1][2], v[1][3]);
                *(u32x4*)(HID + (size_t)(row0 + ai * HALF + m * 16) * FF + col0) = w; }
    }
};
struct EpiDown {
    static constexpr bool PERM = true; static constexpr int HOOK_T = -1;
    h16* Y;
    __device__ __forceinline__ void mid(Acc&, const Unit&, int, int, int, int) const {}
    __device__ __forceinline__ void operator()(const Acc& acc, const Unit& u, int wr, int wc, int fr, int fq) const {
        const int row0 = u.pm * BM + wr * 64 + fr, col0 = u.pn * BM + wc * 32 + 8 * fq;
#pragma unroll
        for (int ai = 0; ai < 2; ++ai) if (ai == 0 || !u.half)
#pragma unroll
            for (int m = 0; m < 4; ++m)
#pragma unroll
                for (int bj = 0; bj < 2; ++bj) {
                    const f32x4 v0 = acc[ai][bj][m][0], v1 = acc[ai][bj][m][1];
                    u32x4 w; w.x = pk2(v0[0], v0[1]); w.y = pk2(v0[2], v0[3]); w.z = pk2(v1[0], v1[1]); w.w = pk2(v1[2], v1[3]);
                    *(u32x4*)(Y + (size_t)(row0 + ai * HALF + m * 16) * D + col0 + bj * HALF) = w; }
    }
};

struct NoSide { __device__ __forceinline__ void issue() {} __device__ __forceinline__ void fin_a(bool) {} __device__ __forceinline__ void fin_b() {} __device__ __forceinline__ void drain() {} };
struct ConvSide {
    const float* Wg; const float* Wu; const float* Wd; unsigned char* ws; LAS unsigned char* scr; int it, stride, lane, pend;
    f32x4 v0, v1, v2, v3; u32x2 t0, t1, t2, t3;
    static constexpr int NITEMS = 3 * 32768;
    __device__ __forceinline__ void locate(int item, const float*& src, int& N, h16*& dst, int& ldo) const {
        if (item < 65536) { const int up = item >> 15, r = item & 32767, e = r >> 10, kb = (r >> 4) & 63, nb = r & 15;
            src = (up ? Wu : Wg) + ((size_t)e * 2048 + 32 * kb) * 512 + 32 * nb; N = 512; dst = (h16*)(ws + WS_WGU) + ((size_t)e * 1024 + up * 512 + 32 * nb) * 2048 + 32 * kb; ldo = 2048; }
        else { const int r = item - 65536, e = r >> 10, kb = (r >> 6) & 15, nb = r & 63;
            src = Wd + ((size_t)e * 512 + 32 * kb) * 2048 + 32 * nb; N = 2048; dst = (h16*)(ws + WS_WDN) + ((size_t)e * 2048 + 32 * nb) * 512 + 32 * kb; ldo = 512; }
    }
    __device__ __forceinline__ void issue() {
        pend = 0;
        if (it < NITEMS) {
            const float* src; int N; h16* dst; int ldo; locate(it, src, N, dst, ldo);
            const unsigned o0 = (unsigned)(((lane >> 3) * N + (lane & 7) * 4) * 4);
            const float* s1 = src + (size_t)8 * N; const float* s2 = s1 + (size_t)8 * N; const float* s3 = s2 + (size_t)8 * N;
            asm volatile("global_load_dwordx4 %0, %4, %5 nt\n\tglobal_load_dwordx4 %1, %4, %6 nt\n\tglobal_load_dwordx4 %2, %4, %7 nt\n\tglobal_load_dwordx4 %3, %4, %8 nt"
                         : "=&v"(v0), "=&v"(v1), "=&v"(v2), "=&v"(v3) : "v"(o0), "s"(src), "s"(s1), "s"(s2), "s"(s3) : "memory");
            pend = 1;
        }
    }
    __device__ __forceinline__ void fin_a(bool all) {
        if (pend) {
            if (all) asm volatile("s_waitcnt vmcnt(0)" : "+v"(v0), "+v"(v1), "+v"(v2), "+v"(v3) :: "memory");
            else     asm volatile("s_waitcnt vmcnt(8)" : "+v"(v0), "+v"(v1), "+v"(v2), "+v"(v3) :: "memory");
            { u32x2 p; p.x = pk2(v0.x, v0.y); p.y = pk2(v0.z, v0.w); *(LAS u32x2*)(scr + ((lane >> 3)) * 72 + (lane & 7) * 8) = p; }
            { u32x2 p; p.x = pk2(v1.x, v1.y); p.y = pk2(v1.z, v1.w); *(LAS u32x2*)(scr + ((lane >> 3) + 8) * 72 + (lane & 7) * 8) = p; }
            { u32x2 p; p.x = pk2(v2.x, v2.y); p.y = pk2(v2.z, v2.w); *(LAS u32x2*)(scr + ((lane >> 3) + 16) * 72 + (lane & 7) * 8) = p; }
            { u32x2 p; p.x = pk2(v3.x, v3.y); p.y = pk2(v3.z, v3.w); *(LAS u32x2*)(scr + ((lane >> 3) + 24) * 72 + (lane & 7) * 8) = p; }
            const int g = lane >> 4, i = lane & 15, nh = g & 1, kh = g >> 1;
            const unsigned ra = (unsigned)(size_t)(scr + (16 * kh + (i >> 2)) * 72 + (16 * nh + 4 * (i & 3)) * 2);
            asm volatile("ds_read_b64_tr_b16 %0, %4\n\tds_read_b64_tr_b16 %1, %4 offset:288\n\tds_read_b64_tr_b16 %2, %4 offset:576\n\tds_read_b64_tr_b16 %3, %4 offset:864"
                         : "=&v"(t0), "=&v"(t1), "=&v"(t2), "=&v"(t3) : "v"(ra) : "memory");
        }
    }
    __device__ __forceinline__ void fin_b() {
        if (pend) {
            asm volatile("s_waitcnt lgkmcnt(0)" : "+v"(t0), "+v"(t1), "+v"(t2), "+v"(t3) :: "memory");
            const float* src; int N; h16* dst; int ldo; locate(it, src, N, dst, ldo);
            const int g = lane >> 4, i = lane & 15, nh = g & 1, kh = g >> 1;
            const u32x4 o0 = {t0.x, t0.y, t1.x, t1.y}, o1 = {t2.x, t2.y, t3.x, t3.y};
            h16* dp = dst + (size_t)(16 * nh + i) * ldo + 16 * kh;
            __builtin_nontemporal_store(o0, (u32x4*)dp); __builtin_nontemporal_store(o1, (u32x4*)(dp + 8));
            it += stride; pend = 0;
        }
    }
    __device__ __forceinline__ void drain() { while (it < NITEMS) { issue(); fin_a(true); fin_b(); } }
};

template <class Epi, class Sched, bool ALIGN_EPI = true, bool HALFSKIP = false, class Side = NoSide>
__device__ __forceinline__ void gemm_phase(LAS unsigned char* lds, const Gemm g, const Sched& S, const Epi& E, Side side = Side()) {
    const int tid = threadIdx.x, wid = __builtin_amdgcn_readfirstlane(tid >> 6), lane = tid & 63, wr = wid >> 2, wc = wid & 3, fr = lane & 15, fq = lane >> 4;
    const int K = g.K, nt = K / BK;
    unsigned voffA[2], voffB[2];
#pragma unroll
    for (int i = 0; i < 2; ++i) { int R, C; stage_rc(tid * 16 + i * 8192, R, C); const int Rb = Epi::PERM ? ((R & ~31) + perm32(R & 31)) : R;
        voffA[i] = (unsigned)(R * K + C) * 2u; voffB[i] = (unsigned)(Rb * K + C) * 2u; }
    const size_t kstep = (size_t)(BK * 2);
    const size_t hstepA = (size_t)HALF * K * 2, hstepB = g.b_hstep;
    const size_t tstepA = 2 * hstepA;
    const unsigned ldsw = (unsigned)wid * 1024u;
    const int aoff = lds_byte(wr * 64 + fr, fq * 8), boff = lds_byte(wc * 32 + fr, fq * 8);
#define PG8_SA(b, h) (((b) * 2 + (h)) * HTB)
#define PG8_SB(b, h) ((4 + (b) * 2 + (h)) * HTB)
#define PG8_STAGE(bufoff, gbase, voff) do { _Pragma("unroll") for (int _i = 0; _i < 2; ++_i) \
        __builtin_amdgcn_global_load_lds((const unsigned*)((const char*)(gbase) + (voff)[_i]), (LAS unsigned*)(lds + (bufoff) + ldsw + _i * 8192), 16, 0, 0); } while (0)
#define PG8_LDA(dst, b, h) do { _Pragma("unroll") for (int m = 0; m < 4; ++m) _Pragma("unroll") for (int k = 0; k < 2; ++k) dst[m][k] = *(const LAS h16x8*)(lds + PG8_SA(b, h) + aoff + m * 2048 + k * 1024); } while (0)
#define PG8_LDB(dst, b, h) do { _Pragma("unroll") for (int n = 0; n < 2; ++n) _Pragma("unroll") for (int k = 0; k < 2; ++k) dst[n][k] = *(const LAS h16x8*)(lds + PG8_SB(b, h) + boff + n * 2048 + k * 1024); } while (0)
#define PG8_MMA(ai, bj, At, Bt) do { __builtin_amdgcn_s_setprio(1); _Pragma("unroll") for (int m = 0; m < 4; ++m) _Pragma("unroll") for (int n = 0; n < 2; ++n) _Pragma("unroll") for (int k = 0; k < 2; ++k) \
        acc[ai][bj][m][n] = __builtin_amdgcn_mfma_f32_16x16x32_f16(Bt[n][k], At[m][k], acc[ai][bj][m][n], 0, 0, 0); __builtin_amdgcn_s_setprio(0); } while (0)
#define PG8_WAIT_V(n) asm volatile("s_waitcnt vmcnt(" #n ")" ::: "memory")
#define PG8_WAIT_L(n) asm volatile("s_waitcnt lgkmcnt(" #n ")" ::: "memory")
#define PG8_BAR __builtin_amdgcn_s_barrier()
#define PG8_SCHED __builtin_amdgcn_sched_barrier(0)
    Unit cur, nxt; int ui = 0;
    if (!S.next(0, cur)) { side.drain(); return; }
    Acc acc;
#pragma unroll
    for (int a = 0; a < 2; ++a)
#pragma unroll
        for (int b = 0; b < 2; ++b)
#pragma unroll
            for (int m = 0; m < 4; ++m)
#pragma unroll
                for (int n = 0; n < 2; ++n) acc[a][b][m][n] = (f32x4){0.f, 0.f, 0.f, 0.f};
    h16x8 At[4][2], B0[2][2], B1[2][2];
    const char* cA = (const char*)g.A + (size_t)cur.pm * tstepA; const char* cB = (const char*)g.Bt + cur.boff;
    PG8_STAGE(PG8_SB(0, 0), cB, voffB); PG8_STAGE(PG8_SB(0, 1), cB + hstepB, voffB); PG8_STAGE(PG8_SA(0, 0), cA, voffA); PG8_STAGE(PG8_SA(0, 1), cA + hstepA, voffA);
    if (wr == 1) PG8_BAR;
    PG8_WAIT_V(2); PG8_BAR;
    PG8_STAGE(PG8_SB(1, 0), cB + kstep, voffB); PG8_STAGE(PG8_SA(1, 0), cA + kstep, voffA); PG8_STAGE(PG8_SB(1, 1), cB + hstepB + kstep, voffB);
    PG8_WAIT_V(6); PG8_BAR;
    for (;;) {
        const bool has_next = S.next(ui + 1, nxt);
        const bool hf = HALFSKIP && __builtin_amdgcn_readfirstlane(cur.half) != 0;
        const char* nA = has_next ? (const char*)g.A + (size_t)nxt.pm * tstepA : cA; const char* nB = has_next ? (const char*)g.Bt + nxt.boff : cB;
        for (int t = 0; t < nt; t += 2) {
            if (Epi::HOOK_T >= 0 && t == Epi::HOOK_T) E.mid(acc, cur, wr, wc, fr, fq);
            const bool last = (t == nt - 2);
            const char* a1 = cA + (size_t)(t + 1) * kstep;
            const char* a2 = last ? nA : cA + (size_t)(t + 2) * kstep; const char* b2 = last ? nB : cB + (size_t)(t + 2) * kstep;
            const char* a3 = a2 + kstep; const char* b3 = b2 + kstep;
            PG8_LDB(B0, 0, 0); PG8_LDB(B1, 0, 1); PG8_SCHED; PG8_LDA(At, 0, 0); PG8_STAGE(PG8_SA(1, 1), a1 + hstepA, voffA);
            PG8_WAIT_V(8); PG8_WAIT_L(0); PG8_BAR; PG8_MMA(0, 0, At, B0); side.issue(); PG8_MMA(0, 1, At, B1); PG8_BAR; PG8_SCHED;
            if (!hf) PG8_LDA(At, 0, 1); PG8_STAGE(PG8_SB(0, 0), b2, voffB); PG8_STAGE(PG8_SB(0, 1), b2 + hstepB, voffB); PG8_STAGE(PG8_SA(0, 0), a2, voffA);
            PG8_WAIT_V(8); PG8_WAIT_L(0); PG8_BAR; if (!hf) { PG8_MMA(1, 0, At, B0); PG8_MMA(1, 1, At, B1); } PG8_BAR; PG8_SCHED;
            PG8_LDB(B0, 1, 0); PG8_LDB(B1, 1, 1); PG8_SCHED; PG8_LDA(At, 1, 0); PG8_STAGE(PG8_SA(0, 1), a2 + hstepA, voffA);
            PG8_WAIT_V(8); PG8_WAIT_L(0); PG8_BAR; PG8_MMA(0, 0, At, B0); side.fin_a(false); PG8_MMA(0, 1, At, B1); PG8_BAR; PG8_SCHED;
            if (!hf) PG8_LDA(At, 1, 1); PG8_STAGE(PG8_SB(1, 0), b3, voffB); PG8_STAGE(PG8_SB(1, 1), b3 + hstepB, voffB); PG8_STAGE(PG8_SA(1, 0), a3, voffA);
            PG8_WAIT_V(8); PG8_WAIT_L(0); PG8_BAR; if (!hf) PG8_MMA(1, 0, At, B0); side.fin_b(); if (!hf) PG8_MMA(1, 1, At, B1); PG8_BAR; PG8_SCHED;
        }
        if constexpr (ALIGN_EPI) { if (wr == 0) PG8_BAR; }
        E(acc, cur, wr, wc, fr, fq);
        if (!has_next) break;
#pragma unroll
        for (int a = 0; a < 2; ++a)
#pragma unroll
            for (int b = 0; b < 2; ++b)
#pragma unroll
                for (int m = 0; m < 4; ++m)
#pragma unroll
                    for (int n = 0; n < 2; ++n) acc[a][b][m][n] = (f32x4){0.f, 0.f, 0.f, 0.f};
        cur = nxt; cA = nA; cB = nB; ++ui;
        if constexpr (ALIGN_EPI) { if (wr == 1) PG8_BAR; }
    }
    PG8_WAIT_V(0);
    if constexpr (!ALIGN_EPI) { if (wr == 0) PG8_BAR; }
    PG8_BAR;
    side.drain();
#undef PG8_SA
#undef PG8_SB
#undef PG8_STAGE
#undef PG8_LDA
#undef PG8_LDB
#undef PG8_MMA
#undef PG8_WAIT_V
#undef PG8_WAIT_L
#undef PG8_BAR
#undef PG8_SCHED
}
}
using pg8::pk2;

constexpr int NWAVES = 8;
constexpr int RING_BYTES = 131072;
constexpr int LDSCTL_OFF = RING_BYTES, MISC_OFF = LDSCTL_OFF + 320;
constexpr int SIDE_OFF = LDSCTL_OFF + 2048, SIDE_WAVE = 2304;
constexpr int LDS_BYTES = SIDE_OFF + 8 * SIDE_WAVE + 1024;

typedef GAS unsigned gu32;
#define RLX_AGENT __ATOMIC_RELAXED, __HIP_MEMORY_SCOPE_AGENT
#define XB_TMO      128
#define XB_XCNT(j)  (256  + 64 * (j))
#define XB_XSUB(j)  (1280 + 64 * (j))
#define XB_XGEN(j)  (2304 + 64 * (j))
#define XB_TOP      3328
#define XB_TOPGEN   3392
#define XCD_BAR_WORDS 3456
#define XB_SPIN_CAP (1u << 18)
__device__ __forceinline__ unsigned xb_ld(unsigned* p)              { return __hip_atomic_load(p, __ATOMIC_RELAXED, __HIP_MEMORY_SCOPE_AGENT); }
__device__ __forceinline__ unsigned xb_add(unsigned* p, unsigned v) { return __hip_atomic_fetch_add(p, v, __ATOMIC_RELAXED, __HIP_MEMORY_SCOPE_AGENT); }
__device__ __forceinline__ unsigned xb_xcc_id() { return (unsigned)__builtin_amdgcn_s_getreg((3 << 11) | 20) & 0xFu; }
#define XB_SPIN(cond, bar) do { unsigned _sp = 0; while (cond) { __builtin_amdgcn_s_sleep(1); \
    if ((++_sp & 255u) == 0u) { if (xb_ld(&(bar)[XB_TMO])) break; if (_sp > XB_SPIN_CAP) { atomicAdd(&(bar)[XB_TMO], 1u); break; } } } } while (0)
struct XcdBarrier { unsigned* bar; unsigned x; volatile LAS unsigned* st; };
__device__ __forceinline__ XcdBarrier xcd_barrier_post(unsigned* bar, volatile LAS unsigned* st) {
    XcdBarrier b; b.bar = bar; b.x = xb_xcc_id(); b.st = st;
    if (threadIdx.x == 0) (void)xb_add(&bar[XB_XCNT(b.x)], 1u);
    return b;
}
__device__ __forceinline__ void xcd_barrier_complete(unsigned* bar, unsigned x, unsigned& nloc, unsigned& nx) {
    const unsigned G = gridDim.x * gridDim.y * gridDim.z;
    unsigned sum, cnt, mine, sp = 0u;
    for (;;) {
        sum = 0u; cnt = 0u; mine = 0u;
#pragma unroll
        for (unsigned j = 0; j < 16; ++j) { const unsigned c = xb_ld(&bar[XB_XCNT(j)]); sum += c; cnt += (c > 0u) ? 1u : 0u; mine = (j == x) ? c : mine; }
        if (sum == G) break;
        __builtin_amdgcn_s_sleep(1);
        if ((++sp & 255u) == 0u) { if (xb_ld(&bar[XB_TMO])) break; if (sp > XB_SPIN_CAP) { atomicAdd(&bar[XB_TMO], 1u); break; } }
    }
    nloc = mine > 0u ? mine : 1u; nx = cnt > 0u ? cnt : 1u;
}
__device__ __forceinline__ void xcd_barrier(const XcdBarrier& b) {
    asm volatile("s_waitcnt vmcnt(0)" ::: "memory");
    __syncthreads();
    if (threadIdx.x == 0) {
        unsigned* bar = b.bar;
        __builtin_amdgcn_s_waitcnt(0);
        unsigned nloc = b.st[0], nx = b.st[1];
        if (nloc == 0u) { xcd_barrier_complete(bar, b.x, nloc, nx); b.st[0] = nloc; b.st[1] = nx; }
        const unsigned old = xb_add(&bar[XB_XSUB(b.x)], 1u);
        const unsigned gen = old / nloc;
        if (old + 1u == (gen + 1u) * nloc) {
            __builtin_amdgcn_fence(__ATOMIC_RELEASE, "agent");
            asm volatile("s_waitcnt vmcnt(0)" ::: "memory");
            const unsigned og = xb_add(&bar[XB_TOP], 1u);
            const unsigned tg = og / nx;
            if (og + 1u == (tg + 1u) * nx) xb_add(&bar[XB_TOPGEN], 1u);
            else XB_SPIN(xb_ld(&bar[XB_TOPGEN]) == tg, bar);
            __builtin_amdgcn_fence(__ATOMIC_ACQUIRE, "agent");
            xb_add(&bar[XB_XGEN(b.x)], 1u);
            asm volatile("s_waitcnt vmcnt(0)" ::: "memory");
        } else {
            XB_SPIN(xb_ld(&bar[XB_XGEN(b.x)]) == gen, bar);
            __builtin_amdgcn_fence(__ATOMIC_ACQUIRE, "agent");
            asm volatile("s_waitcnt vmcnt(0)" ::: "memory");
        }
    }
    __syncthreads();
}

struct Args { const float* in[26]; float* out; unsigned char* ws; int ph_lo, ph_hi, chk, pad; };
struct Frame {
    LAS unsigned char* lds; unsigned char* ws; int tid, lane, wave, G, gw, NGW;
};
#define LDS_WAIT() asm volatile("s_waitcnt lgkmcnt(0)" ::: "memory")
__device__ __forceinline__ float wave_sum(float v) {
#pragma unroll
    for (int o = 1; o < 64; o <<= 1) v += __shfl_xor(v, o);
    return v;
}
__device__ __forceinline__ float gelu_tanh(float x) {
    const float z = 0.7978845608028654f * (x + 0.044715f * x * x * x);
    const float e = __builtin_amdgcn_exp2f(2.0f * LOG2E * z);
    const float th = 1.0f - 2.0f * __builtin_amdgcn_rcpf(e + 1.0f);
    return 0.5f * x * (1.0f + th);
}

__device__ __forceinline__ void p0_transpose_item(const float* W, int N, h16* WT, int ldo, int koff, int row_off, LAS float* scr, int item, int lane) {
    const int nblk = N / 32, kb = item / nblk, nb = item % nblk, k0 = 64 * kb, n0 = 32 * nb;
#pragma unroll 8
    for (int i = 0; i < 32; ++i) { const int kk = 2 * i + (lane >> 5); scr[kk * 33 + (lane & 31)] = W[(size_t)(k0 + kk) * N + n0 + (lane & 31)]; }
    LDS_WAIT(); asm volatile("" ::: "memory");
    const int c = lane & 7;
#pragma unroll
    for (int j = 0; j < 4; ++j) { const int n = (lane >> 3) + 8 * j; const LAS float* s = scr + (8 * c) * 33 + n;
        u32x4 o; o.x = pk2(s[0 * 33], s[1 * 33]); o.y = pk2(s[2 * 33], s[3 * 33]); o.z = pk2(s[4 * 33], s[5 * 33]); o.w = pk2(s[6 * 33], s[7 * 33]);
        *(u32x4*)(WT + (size_t)(row_off + n0 + n) * ldo + koff + k0 + 8 * c) = o; }
    LDS_WAIT(); asm volatile("" ::: "memory");
}
__device__ __forceinline__ void rms_row_to_h16(const float* xrow, const float* gain, h16* orow, int lane) {
    const f32x4* xr = (const f32x4*)xrow + lane; const f32x4* gr = (const f32x4*)gain + lane;
    f32x4 v[8]; float s = 0.f;
#pragma unroll
    for (int j = 0; j < 8; ++j) { v[j] = xr[64 * j]; s += (v[j].x * v[j].x + v[j].y * v[j].y) + (v[j].z * v[j].z + v[j].w * v[j].w); }
    const float r = 1.0f / sqrtf(wave_sum(s) * (1.0f / D) + EPS);
    u32x2* o8 = (u32x2*)orow + lane;
#pragma unroll
    for (int j = 0; j < 8; ++j) { const f32x4 g = gr[64 * j]; u32x2 w; w.x = pk2(v[j].x * r * g.x, v[j].y * r * g.y); w.y = pk2(v[j].z * r * g.z, v[j].w * r * g.w); o8[64 * j] = w; }
}

constexpr int SSM_CHUNK = 256, SSM_NCH = T / SSM_CHUNK;
template <bool FULL>
__device__ __forceinline__ void ssm_wave(const Frame& F, const float* const* in, LAS unsigned char* wl) {
    unsigned char* ws = F.ws; const int lane = F.lane, lq = lane >> 4, lr = lane & 15;
    const h16* PROJ = (const h16*)(ws + WS_PROJ);
    const h16x8 zero8 = {0, 0, 0, 0, 0, 0, 0, 0};
    for (int item = F.gw; item < 64 * SSM_NCH; item += F.NGW) {
        const int g = item & 63, c = item >> 6;
        const f32x4 ab = ((const f32x4*)(ws + WS_AB))[g * 64 + lane];
        const float ar = ab.x, ai = ab.y;
        h16x8 bfrag[8];
#pragma unroll
        for (int mt = 0; mt < 8; ++mt) bfrag[mt] = lq < 2 ? *(const h16x8*)((const h16*)(ws + WS_BB) + ((size_t)(g * 128 + 16 * mt + lr)) * 16 + 8 * lq) : zero8;
        h16x8 cfrag[4]; f32x4 d4 = {0.f, 0.f, 0.f, 0.f};
        if (FULL) {
#pragma unroll
            for (int s = 0; s < 4; ++s) cfrag[s] = *(const h16x8*)((const h16*)(ws + WS_CT) + ((size_t)(g * 16 + lr)) * 128 + 32 * s + 8 * lq);
            d4 = *(const f32x4*)(in[11] + 16 * g + 4 * lq);
        }
        const int t0 = SSM_CHUNK * c;
        h16x8 uf[4], ufn[4]; u32x2 uw[4], uwn[4];
#pragma unroll
        for (int sub = 0; sub < 4; ++sub) {
            uf[sub] = lq < 2 ? *(const h16x8*)(PROJ + (size_t)(t0 + 16 * sub + lr) * INC + COL_U + 16 * g + 8 * lq) : zero8;
            if (FULL) uw[sub] = *(const u32x2*)(PROJ + (size_t)(t0 + 16 * sub + lr) * INC + COL_U + 16 * g + 4 * lq);
        }
        float xr = 0.f, xi = 0.f;
        if (FULL) {
            const f32x2* Sg = (const f32x2*)(ws + WS_S) + (size_t)g * 64 + lane; const float alr = ab.z, ali = ab.w;
#pragma unroll 8
            for (int cc = 0; cc < c; ++cc) { const f32x2 sv = Sg[(size_t)cc * 4096]; const float nr = alr * xr - ali * xi + sv.x, ni = alr * xi + ali * xr + sv.y; xr = nr; xi = ni; }
        }
#pragma unroll 1
        for (int qt = 0; qt < SSM_CHUNK / 64; ++qt) {
            if (qt + 1 < SSM_CHUNK / 64) {
#pragma unroll
                for (int sub = 0; sub < 4; ++sub) {
                    ufn[sub] = lq < 2 ? *(const h16x8*)(PROJ + (size_t)(t0 + 64 * (qt + 1) + 16 * sub + lr) * INC + COL_U + 16 * g + 8 * lq) : zero8;
                    if (FULL) uwn[sub] = *(const u32x2*)(PROJ + (size_t)(t0 + 64 * (qt + 1) + 16 * sub + lr) * INC + COL_U + 16 * g + 4 * lq);
                }
            }
#pragma unroll
            for (int sub = 0; sub < 4; ++sub) {
                const int ts = t0 + 64 * qt + 16 * sub;
#pragma unroll
                for (int mt = 0; mt < 8; ++mt) {
                    f32x4 a = {0.f, 0.f, 0.f, 0.f};
                    a = __builtin_amdgcn_mfma_f32_16x16x32_f16(bfrag[mt], uf[sub], a, 0, 0, 0);
                    *(LAS f32x4*)(wl + lr * 528 + (16 * mt + 4 * lq) * 4) = a;
                }
                f32x2 bu[16];
#pragma unroll
                for (int t = 0; t < 16; ++t) bu[t] = *(const LAS f32x2*)(wl + t * 528 + 8 * lane);
#pragma unroll
                for (int t = 0; t < 16; ++t) {
                    const float nr = ar * xr - ai * xi + bu[t].x, ni = ar * xi + ai * xr + bu[t].y; xr = nr; xi = ni;
                    if (FULL) *(LAS unsigned*)(wl + t * 528 + 4 * lane) = pk2(xr, xi);
                }
                if (FULL) {
                    f32x4 y = {0.f, 0.f, 0.f, 0.f};
#pragma unroll
                    for (int s = 0; s < 4; ++s) { const h16x8 xf = *(const LAS h16x8*)(wl + lr * 528 + (32 * s + 8 * lq) * 2); y = __builtin_amdgcn_mfma_f32_16x16x32_f16(cfrag[s], xf, y, 0, 0, 0); }
                    const f32x4 u4 = pg8::h4_to_f4(uw[sub]);
                    f32x4 o;
#pragma unroll
                    for (int e = 0; e < 4; ++e) o[e] = gelu_tanh(y[e] + d4[e] * u4[e]);
                    u32x2 w; w.x = pk2(o[0], o[1]); w.y = pk2(o[2], o[3]);
                    *(u32x2*)((h16*)(ws + WS_YG) + (size_t)(ts + lr) * SSMW + 16 * g + 4 * lq) = w;
                }
            }
#pragma unroll
            for (int sub = 0; sub < 4; ++sub) { uf[sub] = ufn[sub]; if (FULL) uw[sub] = uwn[sub]; }
        }
        if (!FULL) ((f32x2*)(ws + WS_S))[(size_t)c * 4096 + g * 64 + lane] = (f32x2){xr, xi};
    }
}

__device__ __forceinline__ s16x4 tr_read(const LAS unsigned char* p) {
    typedef short v4i16_t __attribute__((ext_vector_type(4)));
    return __builtin_amdgcn_ds_read_tr16_b64_v4i16((LAS v4i16_t*)p);
}
__device__ __forceinline__ void attn_pair(const Frame& F, int item0) {
    unsigned char* ws = F.ws; const int tid = F.tid, lane = F.lane, wave = F.wave;
    const int half = wave >> 2, qt = wave & 3, r = lane & 31, hh = lane >> 5;
    const int item = item0 + half;
    const int g = item >> 9, hs = (item >> 6) & 7, blk = item & 63;
    const int dl = (g == 0) ? 0 : (g == 1 ? 2 : 4), dil = 1 << dl, res = blk & (dil - 1), n = blk >> dl;
    const h16* PROJ = (const h16*)(ws + WS_PROJ);
    const int hcol = (g * 8 + hs) * 64;
    LAS unsigned char* kimg = F.lds + half * 65536; LAS unsigned char* vimg = kimg + 32768;
    const int t2 = tid & 255, c8 = t2 & 7;
    u32x4 vst[8], kst[8];
#pragma unroll
    for (int j = 0; j < 8; ++j) {
        const int kj = (t2 >> 3) + 32 * j, idx = (n - 1) * 128 + kj;
        vst[j] = (u32x4){0u, 0u, 0u, 0u}; kst[j] = vst[j];
        if (idx >= 0) { const h16* rowp = PROJ + (size_t)(idx * dil + res) * INC + hcol + 8 * c8; kst[j] = *(const u32x4*)(rowp + COL_K); vst[j] = *(const u32x4*)(rowp + COL_V); }
    }
    const int qpos = ((n * 128 + 32 * qt + r) << dl) + res;
    h16x8 qf[4];
#pragma unroll
    for (int s = 0; s < 4; ++s) qf[s] = *(const h16x8*)(PROJ + (size_t)qpos * INC + hcol + 16 * s + 8 * hh);
    __builtin_amdgcn_sched_barrier(0);
#pragma unroll
    for (int j = 0; j < 8; ++j) { const int kj = (t2 >> 3) + 32 * j;
        *(LAS u32x4*)(kimg + kj * 128 + ((c8 ^ (kj & 7)) << 4)) = kst[j];
        *(LAS u32x4*)(vimg + kj * 128 + c8 * 16) = vst[j]; }
    __syncthreads();
    const float c1 = 0.125f * LOG2E, c2 = __builtin_amdgcn_exp2f(-(float)(hs + 1)) * (float)dil * LOG2E;
    float mx = -INFINITY;
    f32x16 sc[5];
#pragma unroll
    for (int k5 = 0; k5 < 5; ++k5) {
        const int krow = 32 * (qt + k5) + r;
        f32x16 a = {0.f, 0.f, 0.f, 0.f, 0.f, 0.f, 0.f, 0.f, 0.f, 0.f, 0.f, 0.f, 0.f, 0.f, 0.f, 0.f};
#pragma unroll
        for (int s = 0; s < 4; ++s) { const h16x8 kf = *(const LAS h16x8*)(kimg + krow * 128 + (((2 * s + hh) ^ (krow & 7)) << 4)); a = __builtin_amdgcn_mfma_f32_32x32x16_f16(kf, qf[s], a, 0, 0, 0); }
        const int sbase = 128 + r - 32 * k5 - 4 * hh;
        const bool tile_ok = (n > 0) || (qt + k5 >= 4);
        const float fb = -c2 * (float)sbase;
#pragma unroll
        for (int i = 0; i < 16; ++i) {
            const int ci = (i & 3) + 8 * (i >> 2);
            const bool ok = tile_ok && ((unsigned)(sbase - ci) <= 128u);
            const float v = ok ? __builtin_fmaf(a[i], c1, fb + c2 * (float)ci) : -INFINITY;
            a[i] = v; mx = fmaxf(mx, v);
        }
        sc[k5] = a;
    }
    mx = fmaxf(mx, __shfl_xor(mx, 32));
    float l = 0.f;
#pragma unroll
    for (int k5 = 0; k5 < 5; ++k5)
#pragma unroll
        for (int i = 0; i < 16; ++i) { const float p = __builtin_amdgcn_exp2f(sc[k5][i] - mx); sc[k5][i] = p; l += p; }
    l += __shfl_xor(l, 32);
    f32x16 o0 = {0.f, 0.f, 0.f, 0.f, 0.f, 0.f, 0.f, 0.f, 0.f, 0.f, 0.f, 0.f, 0.f, 0.f, 0.f, 0.f}, o1 = o0;
    const int vq = (lane & 15) >> 2, vp = lane & 3, vg = (lane >> 4) & 1;
    const LAS unsigned char* vb = vimg + (4 * hh + vq) * 128 + (16 * vg + 4 * vp) * 2;
#pragma unroll
    for (int k5 = 0; k5 < 5; ++k5)
#pragma unroll
        for (int s = 0; s < 2; ++s) {
            u32x4 pw; pw.x = pk2(sc[k5][8 * s + 0], sc[k5][8 * s + 1]); pw.y = pk2(sc[k5][8 * s + 2], sc[k5][8 * s + 3]); pw.z = pk2(sc[k5][8 * s + 4], sc[k5][8 * s + 5]); pw.w = pk2(sc[k5][8 * s + 6], sc[k5][8 * s + 7]);
            const h16x8 pf = __builtin_bit_cast(h16x8, pw);
            const LAS unsigned char* vr = vb + (32 * (qt + k5) + 16 * s) * 128;
            const s16x4 a0 = tr_read(vr), a1 = tr_read(vr + 8 * 128), b0 = tr_read(vr + 64), b1 = tr_read(vr + 8 * 128 + 64);
            typedef short s16x8 __attribute__((ext_vector_type(8)));
            const s16x8 va = {a0[0], a0[1], a0[2], a0[3], a1[0], a1[1], a1[2], a1[3]}, vbb = {b0[0], b0[1], b0[2], b0[3], b1[0], b1[1], b1[2], b1[3]};
            o0 = __builtin_amdgcn_mfma_f32_32x32x16_f16(__builtin_bit_cast(h16x8, va), pf, o0, 0, 0, 0);
            o1 = __builtin_amdgcn_mfma_f32_32x32x16_f16(__builtin_bit_cast(h16x8, vbb), pf, o1, 0, 0, 0);
        }
    const float il = 1.0f / l;
    h16* og = (h16*)(ws + WS_OG) + ((size_t)g * T + qpos) * 512 + hs * 64;
#pragma unroll
    for (int q4 = 0; q4 < 4; ++q4) {
        u32x2 w; w.x = pk2(o0[4 * q4] * il, o0[4 * q4 + 1] * il); w.y = pk2(o0[4 * q4 + 2] * il, o0[4 * q4 + 3] * il);
        *(u32x2*)(og + 8 * q4 + 4 * hh) = w;
        w.x = pk2(o1[4 * q4] * il, o1[4 * q4 + 1] * il); w.y = pk2(o1[4 * q4 + 2] * il, o1[4 * q4 + 3] * il);
        *(u32x2*)(og + 32 + 8 * q4 + 4 * hh) = w;
    }
    if (hh == 0) ((float*)(ws + WS_LSE))[((size_t)g * T + qpos) * 8 + hs] = mx * LN2 + __logf(l);
    __syncthreads();
}


#ifndef DBGCHK
#define DBGCHK 0
#endif
constexpr int CW_DBG = 12288;
__device__ __forceinline__ unsigned hsh(unsigned x) { x ^= x >> 16; x *= 0x7feb352du; x ^= x >> 15; x *= 0x846ca68bu; x ^= x >> 16; return x; }
__device__ __forceinline__ void chk_fail(unsigned* ctl, int code) { atomicMax(ctl + CW_DBG, (unsigned)(100 - code)); }
__device__ __forceinline__ bool close_(float a, float b) { return fabsf(a - b) <= 0.01f * fabsf(b) + 0.01f && a == a; }
__device__ __forceinline__ float dot_hh(const h16* a, const h16* b, int K) { float s = 0.f; for (int k = 0; k < K; ++k) s += (float)a[k] * (float)b[k]; return s; }
__device__ __forceinline__ void run_checks(int after, const float* const* in, unsigned char* ws, unsigned* ctl, int tid) {
    const unsigned r0 = hsh(tid * 7919u + after * 104729u + 12345u), r1 = hsh(r0 + 1u), r2 = hsh(r1 + 7u);
    const h16* PROJ = (const h16*)(ws + WS_PROJ);
    if (after == 0) {
        {
            const int row = r0 % T, col = r1 % D; const float* xr = in[0] + (size_t)row * D; float ss = 0.f;
            for (int k = 0; k < D; ++k) ss += xr[k] * xr[k];
            const float v = xr[col] / sqrtf(ss / D + EPS) * in[1][col];
            if (!close_((float)((const h16*)(ws + WS_H))[(size_t)row * D + col], v)) chk_fail(ctl, 1);
        }
        {
            int n = r1 % INC, k = r2 % D;
            if (!close_((float)((const h16*)(ws + WS_WIN))[(size_t)n * D + k], in[2][(size_t)k * INC + n])) chk_fail(ctl, 2);
            n = r1 % 1024; k = r2 % 1024;
            if (!close_((float)((const h16*)(ws + WS_WGLU))[(size_t)n * 1024 + k], in[12][(size_t)k * 1024 + n])) chk_fail(ctl, 2);
            n = r1 % D; k = r2 % 512;
            if (!close_((float)((const h16*)(ws + WS_WUP))[(size_t)n * 1536 + k], in[14][(size_t)k * D + n])) chk_fail(ctl, 2);
            k = r2 % 1024;
            if (!close_((float)((const h16*)(ws + WS_WUP))[(size_t)n * 1536 + 512 + k], in[15][(size_t)k * D + n])) chk_fail(ctl, 2);
            k = r2 % D;
            if (!close_((float)((const h16*)(ws + WS_WOUT))[(size_t)n * D + k], in[16][(size_t)k * D + n])) chk_fail(ctl, 2);
        }
    }
    if (after == 1) {
        int n, k;
        const int e = r0 % NE; n = r1 % FF; k = r2 % D;
        if (!close_((float)((const h16*)(ws + WS_WGU))[((size_t)e * 1024 + n) * D + k], in[22][((size_t)e * D + k) * FF + n])) chk_fail(ctl, 2);
        if (!close_((float)((const h16*)(ws + WS_WGU))[((size_t)e * 1024 + 512 + n) * D + k], in[23][((size_t)e * D + k) * FF + n])) chk_fail(ctl, 2);
        n = r1 % D; k = r2 % FF;
        if (!close_((float)((const h16*)(ws + WS_WDN))[((size_t)e * D + n) * FF + k], in[24][((size_t)e * FF + k) * D + n])) chk_fail(ctl, 2);
    }
    if (after == 1) {
        const int row = r0 % T; int col = r1 % INC; if (tid & 1) col = COL_G + (r1 % 4096);
        float v = dot_hh((const h16*)(ws + WS_H) + (size_t)row * D, (const h16*)(ws + WS_WIN) + (size_t)col * D, D);
        if (col >= COL_G) v = 1.f / (1.f + expf(-(v + in[3][col - COL_G])));
        if (!close_((float)PROJ[(size_t)row * INC + col], v)) chk_fail(ctl, 3);
    }
    if (after == 2) {
        const int g = r0 % 3, t = r1 % T, hs = r2 % 8, dil = (g == 0) ? 1 : (g == 1 ? 4 : 16), hcol = (g * 8 + hs) * 64;
        const float slope = exp2f(-(float)(hs + 1));
        const h16* q = PROJ + (size_t)t * INC + hcol;
        float mx = -INFINITY;
        for (int j = 0; j <= 128; ++j) { const int tk = t - j * dil; if (tk < 0) break; const float sc = dot_hh(q, PROJ + (size_t)tk * INC + COL_K + hcol, 64) * 0.125f - slope * (float)(dil * j); mx = fmaxf(mx, sc); }
        float l = 0.f, o0 = 0.f, o1 = 0.f; const int d0 = r2 % 64, d1 = (r2 >> 8) % 64;
        for (int j = 0; j <= 128; ++j) { const int tk = t - j * dil; if (tk < 0) break; const float sc = dot_hh(q, PROJ + (size_t)tk * INC + COL_K + hcol, 64) * 0.125f - slope * (float)(dil * j);
            const float p = expf(sc - mx); l += p; o0 += p * (float)PROJ[(size_t)tk * INC + COL_V + hcol + d0]; o1 += p * (float)PROJ[(size_t)tk * INC + COL_V + hcol + d1]; }
        const h16* og = (const h16*)(ws + WS_OG) + ((size_t)g * T + t) * 512 + hs * 64;
        if (!close_((float)og[d0], o0 / l) || !close_((float)og[d1], o1 / l)) chk_fail(ctl, 4);
        if (!close_(((const float*)(ws + WS_LSE))[((size_t)g * T + t) * 8 + hs], mx + logf(l))) chk_fail(ctl, 5);
    }
    if (after == 3) {
        {
            const int t = r0 % T, hs = r1 % 8, d = r2 % 64; const float* LSE = (const float*)(ws + WS_LSE);
            float lse[3], m = -INFINITY; for (int g = 0; g < 3; ++g) { lse[g] = LSE[((size_t)g * T + t) * 8 + hs]; m = fmaxf(m, lse[g]); }
            float den = 0.f, num = 0.f; for (int g = 0; g < 3; ++g) { const float w = expf(lse[g] - m); den += w; num += w * (float)((const h16*)(ws + WS_OG))[((size_t)g * T + t) * 512 + hs * 64 + d]; }
            const h16 av = ((const h16*)(ws + WS_ACAT))[(size_t)t * 1536 + hs * 64 + d]; const float bv = num / den;
            if (__builtin_bit_cast(unsigned short, av) == 0xAAAAu) chk_fail(ctl, 6);
            else if (!(fabsf(bv) < 1e30f)) chk_fail(ctl, 7);
            else if (!close_((float)av, bv)) { chk_fail(ctl, 8); atomicAdd(ctl + CW_DBG + 1, 1u); if (t < 2048) atomicAdd(ctl + CW_DBG + 2, 1u); }
        }
        {
            const int wv = tid >> 6, p = tid & 63, gq = (wv * 9 + 3) % 64, gp = gq * 64 + p;
            const float are = in[4][gp], aim = in[5][gp], step = expf(in[6][gq]), mag = expf(are * step), ang = aim * step;
            const float br = mag * cosf(ang), bi = mag * sinf(ang), nr = br - 1.f, ni = bi, den = are * are + aim * aim;
            const float fr_ = (nr * are + ni * aim) / den, fi_ = (ni * are - nr * aim) / den;
            float bbr[16], bbi[16];
#pragma unroll
            for (int h = 0; h < 16; ++h) { const float b_r = in[7][(size_t)gp * 16 + h], b_i = in[8][(size_t)gp * 16 + h]; bbr[h] = fr_ * b_r - fi_ * b_i; bbi[h] = fr_ * b_i + fi_ * b_r; }
            float xr = 0.f, xi = 0.f; int ci = 0, tn = 5;
            for (int t = 0; t < T; ++t) {
                float bur = 0.f, bui = 0.f;
#pragma unroll
                for (int h = 0; h < 16; ++h) { const float u = (float)PROJ[(size_t)t * INC + COL_U + gq * 16 + h]; bur += bbr[h] * u; bui += bbi[h] * u; }
                const float nr2 = br * xr - bi * xi + bur, ni2 = br * xi + bi * xr + bui; xr = nr2; xi = ni2;
                if (t == tn) {
                    for (int h = 0; h < 16; ++h) {
                        float yv = in[9][((size_t)gq * 16 + h) * 64 + p] * xr - in[10][((size_t)gq * 16 + h) * 64 + p] * xi;
                        yv = wave_sum(yv);
                        yv += in[11][gq * 16 + h] * (float)PROJ[(size_t)t * INC + COL_U + gq * 16 + h];
                        const float z = 0.7978845608028654f * (yv + 0.044715f * yv * yv * yv), ge = 0.5f * yv * (1.f + tanhf(z));
                        if (p == 0 && !close_((float)((const h16*)(ws + WS_YG))[(size_t)t * SSMW + gq * 16 + h], ge)) chk_fail(ctl, 9);
                    }
                    ++ci; tn = (ci == 1) ? 64 + wv : (ci == 2 ? 1000 + 17 * wv : T - 1);
                }
            }
        }
    }
    if (after == 4) {
        const int row = r0 % T, c = r1 % 1024; const h16* yg = (const h16*)(ws + WS_YG) + (size_t)row * SSMW;
        const float v = dot_hh(yg, (const h16*)(ws + WS_WGLU) + (size_t)c * 1024, 1024) + in[13][c];
        if (!close_((float)((const h16*)(ws + WS_ACAT))[(size_t)row * 1536 + 512 + c], (float)yg[c] / (1.f + expf(-v)))) chk_fail(ctl, 10);
    }
    if (after == 5) {
        const int row = r0 % T, c = r1 % D; const h16* a = (const h16*)(ws + WS_ACAT) + (size_t)row * 1536; const h16* w = (const h16*)(ws + WS_WUP) + (size_t)c * 1536;
        const float va = dot_hh(a, w, 512), vs = dot_hh(a + 512, w + 512, 1024);
        const float ga = (float)PROJ[(size_t)row * INC + COL_G + c], gs = (float)PROJ[(size_t)row * INC + COL_G + D + c];
        if (!close_((float)((const h16*)(ws + WS_MERGED))[(size_t)row * D + c], ga * va + gs * vs)) chk_fail(ctl, 11);
    }
    if (after == 6) {
        const int row = r0 % T, c = r1 % D;
        const float v = in[0][(size_t)row * D + c] + dot_hh((const h16*)(ws + WS_MERGED) + (size_t)row * D, (const h16*)(ws + WS_WOUT) + (size_t)c * D, D);
        if (!close_(((const float*)(ws + WS_X1))[(size_t)row * D + c], v)) chk_fail(ctl, 12);
    }
}

__global__ void __launch_bounds__(NWAVES * 64, 2) fwd_kernel(Args args) {
    extern __shared__ __attribute__((aligned(16))) unsigned char lds_raw[];
    Frame F;
    F.lds = (LAS unsigned char*)lds_raw; F.ws = args.ws;
    F.tid = threadIdx.x; F.lane = F.tid & 63; F.wave = __builtin_amdgcn_readfirstlane(F.tid >> 6);
    F.G = gridDim.x; F.gw = blockIdx.x * NWAVES + F.wave; F.NGW = F.G * NWAVES;
    unsigned char* ws = args.ws;
    const float* const* in = args.in;
    volatile LAS unsigned* MISC = (volatile LAS unsigned*)(F.lds + MISC_OFF);
    for (int u = F.tid; u < (LDS_BYTES - LDSCTL_OFF) / 4; u += NWAVES * 64) ((LAS unsigned*)(F.lds + LDSCTL_OFF))[u] = 0u;
    __syncthreads();
    unsigned* ctl = (unsigned*)(ws + WS_CTL);
    XcdBarrier bar; bar.bar = ctl + CW_BAR; bar.x = 0; bar.st = nullptr;
    if (MK_N_LAUNCHES == 1) bar = xcd_barrier_post(ctl + CW_BAR, MISC + 8);
    const int lo = args.ph_lo, hi = args.ph_hi;
#ifndef PH_MASK
#define PH_MASK 0xFFF
#endif
#define IN(k) ((((PH_MASK) >> (k)) & 1) && lo <= (k) && (k) < hi)
#ifndef DUP_MASK
#define DUP_MASK 0
#endif
#define REPS(k) (1 + (((DUP_MASK) >> (k)) & 1))
#ifndef XBAR
#define XBAR 1
#endif
#ifndef TSA
#define TSA -1
#endif
#ifndef TSB
#define TSB -1
#endif
    unsigned long long* tsw = (unsigned long long*)(ws + WS_CTL + 40960);
#define STAMP(k) do { if (TSB >= 0 && blockIdx.x == 0 && tid == 0) tsw[k] = __builtin_amdgcn_s_memrealtime(); } while (0)
#define SEAM(k) do { if (IN(k) && IN((k) + 1)) for (int b_ = 0; b_ < XBAR; ++b_) xcd_barrier(bar); STAMP((k) + 1); } while (0)
    const int lane = F.lane, wave = F.wave, tid = F.tid;
    STAMP(0);
    if (DBGCHK && args.chk > 0) { if (blockIdx.x == 0) run_checks(args.chk - 1, in, ws, ctl, tid); return; }

    if (IN(0)) for (int rep_ = 0; rep_ < REPS(0); ++rep_) {
        LAS float* scr = (LAS float*)(F.lds + wave * 16384);
        const int gw = F.gw, NGW = F.NGW;
        constexpr int I_IN = (D / 64) * (INC / 32), I_GLU = (1024 / 64) * (1024 / 32), I_UA = (512 / 64) * (D / 32), I_US = (1024 / 64) * (D / 32), I_OUT = (D / 64) * (D / 32);
        constexpr int I_EG = (D / 64) * (FF / 32), I_ED = (FF / 64) * (D / 32);
        constexpr int NIT = I_IN + I_GLU + I_UA + I_US + I_OUT;
        for (int it = gw; it < NIT; it += NGW) {
            int rr = it;
            if (rr < I_IN) { p0_transpose_item(in[2], INC, (h16*)(ws + WS_WIN), D, 0, 0, scr, rr, lane); continue; } rr -= I_IN;
            if (rr < I_GLU) { p0_transpose_item(in[12], 1024, (h16*)(ws + WS_WGLU), 1024, 0, 0, scr, rr, lane); continue; } rr -= I_GLU;
            if (rr < I_UA) { p0_transpose_item(in[14], D, (h16*)(ws + WS_WUP), 1536, 0, 0, scr, rr, lane); continue; } rr -= I_UA;
            if (rr < I_US) { p0_transpose_item(in[15], D, (h16*)(ws + WS_WUP), 1536, 512, 0, scr, rr, lane); continue; } rr -= I_US;
            p0_transpose_item(in[16], D, (h16*)(ws + WS_WOUT), D, 0, 0, scr, rr, lane);
        }
        for (int m = gw; m < T; m += NGW) rms_row_to_h16(in[0] + (size_t)m * D, in[1], (h16*)(ws + WS_H) + (size_t)m * D, lane);
        {
            const int gt = blockIdx.x * (NWAVES * 64) + tid;
            if (gt < 4096) {
                const int g = gt >> 6, p = gt & 63;
                const float are = in[4][gt], aim = in[5][gt], step = expf(in[6][g]);
                const float mag = expf(are * step), ang = aim * step;
                float sn, cs; sincosf(ang, &sn, &cs);
                const float br = mag * cs, bi = mag * sn;
                float pr = br, pi = bi;
#pragma unroll
                for (int k = 0; k < 8; ++k) { const float nr2 = pr * pr - pi * pi, ni2 = 2.f * pr * pi; pr = nr2; pi = ni2; }
                ((f32x4*)(ws + WS_AB))[gt] = (f32x4){br, bi, pr, pi};
                const float nr = br - 1.0f, ni = bi, den = are * are + aim * aim;
                const float fr_ = (nr * are + ni * aim) / den, fi_ = (ni * are - nr * aim) / den;
                h16* BB = (h16*)(ws + WS_BB) + ((size_t)g * 128 + 2 * p) * 16;
                const float* bre = in[7] + (size_t)gt * 16; const float* bim = in[8] + (size_t)gt * 16;
#pragma unroll
                for (int h = 0; h < 16; ++h) { BB[h] = (h16)(fr_ * bre[h] - fi_ * bim[h]); BB[16 + h] = (h16)(fr_ * bim[h] + fi_ * bre[h]); }
                h16* CT = (h16*)(ws + WS_CT) + (size_t)g * 16 * 128 + 2 * p;
#pragma unroll
                for (int h = 0; h < 16; ++h) { CT[h * 128] = (h16)in[9][((size_t)g * 16 + h) * 64 + p]; CT[h * 128 + 1] = (h16)(-in[10][((size_t)g * 16 + h) * 64 + p]); }
            }
        }
        for (int i = blockIdx.x * (NWAVES * 64) + tid; i < D * 64; i += F.G * NWAVES * 64) {
            const int k = i >> 6, j = i & 63; const float gn = in[17][k];
            float v = 0.f; if (j < 32) v = in[20][k * 32 + j] * gn; else if (j < 36) v = in[18][k * 4 + (j - 32)] * gn;
            ((float*)(ws + WS_WR))[(((k >> 2) * 64 + j) << 2) + (k & 3)] = v;
        }
    }
    SEAM(0);

    if (TSB >= 0 && blockIdx.x == 0 && tid == 0) tsw[24] = __builtin_amdgcn_s_memtime() >> 5;
    if (IN(1)) for (int rep_ = 0; rep_ < REPS(1); ++rep_) {
        pg8::Gemm g{(const h16*)(ws + WS_H), (const h16*)(ws + WS_WIN), D, (size_t)pg8::HALF * D * 2};
        pg8::StaticOrder S; S.init(T, INC, D, F.G, (int)blockIdx.x);
        pg8::EpiProj E{(h16*)(ws + WS_PROJ), in[3]};
        pg8::ConvSide side; side.Wg = in[22]; side.Wu = in[23]; side.Wd = in[24]; side.ws = ws;
        side.scr = F.lds + SIDE_OFF + wave * SIDE_WAVE; side.it = F.gw; side.stride = F.NGW; side.lane = lane; side.pend = 0;
        pg8::gemm_phase<pg8::EpiProj, pg8::StaticOrder, true, false, pg8::ConvSide>(F.lds, g, S, E, side);
    }
    if (TSB >= 0 && blockIdx.x == 0 && tid == 0) { tsw[25] = __builtin_amdgcn_s_memtime() >> 5; tsw[26] = __builtin_amdgcn_s_memrealtime(); }
    SEAM(1);

    if (IN(2)) for (int rep_ = 0; rep_ < REPS(2); ++rep_) {
#ifndef NO_ATTN
        for (int it = blockIdx.x; it < 768; it += F.G) attn_pair(F, 2 * it);
#endif
#ifndef NO_SSM1
        ssm_wave<false>(F, in, F.lds + wave * 16384);
#endif
    }
    SEAM(2);

    if (IN(3)) for (int rep_ = 0; rep_ < REPS(3); ++rep_) {
        for (int i = blockIdx.x * (NWAVES * 64) + tid; i < T * 64; i += F.G * NWAVES * 64) {
            const int t = i >> 6, hsl = (i >> 3) & 7, c8 = i & 7;
            const float* LSE = (const float*)(ws + WS_LSE);
            const float l0 = LSE[((size_t)0 * T + t) * 8 + hsl], l1 = LSE[((size_t)1 * T + t) * 8 + hsl], l2 = LSE[((size_t)2 * T + t) * 8 + hsl];
            const float m = fmaxf(l0, fmaxf(l1, l2));
            float w0 = __expf(l0 - m), w1 = __expf(l1 - m), w2 = __expf(l2 - m); const float inv = 1.0f / (w0 + w1 + w2); w0 *= inv; w1 *= inv; w2 *= inv;
            const h16* OG = (const h16*)(ws + WS_OG) + (size_t)t * 512 + hsl * 64 + c8 * 8;
            const u32x4 a = *(const u32x4*)OG, b = *(const u32x4*)(OG + (size_t)T * 512), cc = *(const u32x4*)(OG + (size_t)2 * T * 512);
            u32x4 o;
#pragma unroll
            for (int e = 0; e < 4; ++e) {
                const h16x2 ha = pg8::as_h2(a[e]), hb = pg8::as_h2(b[e]), hc = pg8::as_h2(cc[e]);
                o[e] = pk2(w0 * (float)ha.x + w1 * (float)hb.x + w2 * (float)hc.x, w0 * (float)ha.y + w1 * (float)hb.y + w2 * (float)hc.y);
            }
            if (DBG & 1) o = (u32x4){0u, 0u, 0u, 0u};
            *(u32x4*)((h16*)(ws + WS_ACAT) + (size_t)t * 1536 + hsl * 64 + c8 * 8) = o;
        }
        ssm_wave<true>(F, in, F.lds + wave * 16384);
    }
    SEAM(3);

    if (IN(4)) for (int rep_ = 0; rep_ < REPS(4); ++rep_) {
        pg8::Gemm g{(const h16*)(ws + WS_YG), (const h16*)(ws + WS_WGLU), 1024, (size_t)pg8::HALF * 1024 * 2};
        pg8::StaticOrder S; S.init(T, 1024, 1024, F.G, (int)blockIdx.x);
        pg8::EpiGlu E{(const h16*)(ws + WS_YG), (h16*)(ws + WS_ACAT), in[13]};
        pg8::gemm_phase<pg8::EpiGlu, pg8::StaticOrder>(F.lds, g, S, E);
    }
    SEAM(4);

    if (IN(5)) for (int rep_ = 0; rep_ < REPS(5); ++rep_) {
        pg8::Gemm g{(const h16*)(ws + WS_ACAT), (const h16*)(ws + WS_WUP), 1536, (size_t)pg8::HALF * 1536 * 2};
        pg8::StaticOrder S; S.init(T, D, 1536, F.G, (int)blockIdx.x);
        pg8::EpiUp E{(const h16*)(ws + WS_PROJ), (h16*)(ws + WS_MERGED)};
        pg8::gemm_phase<pg8::EpiUp, pg8::StaticOrder>(F.lds, g, S, E);
    }
    SEAM(5);

    if (IN(6)) for (int rep_ = 0; rep_ < REPS(6); ++rep_) {
        pg8::Gemm g{(const h16*)(ws + WS_MERGED), (const h16*)(ws + WS_WOUT), D, (size_t)pg8::HALF * D * 2};
        pg8::StaticOrder S; S.init(T, D, D, F.G, (int)blockIdx.x);
        pg8::EpiOut E{in[0], (float*)(ws + WS_X1)};
        pg8::gemm_phase<pg8::EpiOut, pg8::StaticOrder>(F.lds, g, S, E);
    }
    SEAM(6);

    if (IN(7)) for (int rep_ = 0; rep_ < REPS(7); ++rep_) {
        const float* X1 = (const float*)(ws + WS_X1); const float* WR = (const float*)(ws + WS_WR);
        STAMP(16);
        LAS float* part = (LAS float*)F.lds;
        LAS f32x4* sinfo = (LAS f32x4*)(F.lds + 8 * 32 * 40 * 4);
        LAS float* red = (LAS float*)(F.lds + 41984);
        LAS float* xt = (LAS float*)(F.lds + 47104) + wave * (32 * 36);
        LAS float* wgs = (LAS float*)(F.lds + 83968) + wave * 1024;
        for (int tb = blockIdx.x; tb < T / 32; tb += F.G) {
            const int t0 = tb * 32, i = lane & 31, kk = lane >> 5, kbase = wave * 256;
            f32x16 ae = {0.f, 0.f, 0.f, 0.f, 0.f, 0.f, 0.f, 0.f, 0.f, 0.f, 0.f, 0.f, 0.f, 0.f, 0.f, 0.f};
            float ss = 0.f, g0 = 0.f, g1 = 0.f, g2 = 0.f, g3 = 0.f;
            const f32x4* wq = (const f32x4*)WR + (size_t)(kbase / 4 + kk) * 64 + i;
            { const f32x4* gsrc = (const f32x4*)WR + ((size_t)(kbase / 4 + lane) * 64 + 32);
#pragma unroll
              for (int g = 0; g < 4; ++g) *(LAS f32x4*)(wgs + lane * 16 + g * 4) = gsrc[g]; }
            const float* xsrc = X1 + (size_t)t0 * D + kbase + 4 * (lane & 7);
            f32x4 xr[4];
#pragma unroll
            for (int q = 0; q < 4; ++q) xr[q] = *(const f32x4*)(xsrc + (size_t)(8 * q + (lane >> 3)) * D);
#pragma unroll 1
            for (int sc_ = 0; sc_ < 8; ++sc_) {
                f32x4 we[4];
#pragma unroll
                for (int m = 0; m < 4; ++m) we[m] = wq[(size_t)(sc_ * 4 + m) * 128];
#pragma unroll
                for (int q = 0; q < 4; ++q) *(LAS f32x4*)(xt + (8 * q + (lane >> 3)) * 36 + 4 * (lane & 7)) = xr[q];
                if (sc_ < 7) {
#pragma unroll
                    for (int q = 0; q < 4; ++q) xr[q] = *(const f32x4*)(xsrc + (size_t)(8 * q + (lane >> 3)) * D + 32 * (sc_ + 1)); }
#pragma unroll
                for (int m = 0; m < 4; ++m) {
                    const f32x4 xv = *(const LAS f32x4*)(xt + i * 36 + 8 * m + 4 * kk);
                    const LAS f32x4* gw4 = (const LAS f32x4*)(wgs + (8 * sc_ + 2 * m + kk) * 16);
                    const f32x4 w0 = gw4[0], w1 = gw4[1], w2 = gw4[2], w3 = gw4[3];
                    ss += (xv.x * xv.x + xv.y * xv.y) + (xv.z * xv.z + xv.w * xv.w);
#pragma unroll
                    for (int e = 0; e < 4; ++e) {
                        ae = __builtin_amdgcn_mfma_f32_32x32x2f32(xv[e], we[m][e], ae, 0, 0, 0);
                        g0 += xv[e] * w0[e]; g1 += xv[e] * w1[e]; g2 += xv[e] * w2[e]; g3 += xv[e] * w3[e];
                    }
                }
            }
            ss += __shfl_xor(ss, 32); g0 += __shfl_xor(g0, 32); g1 += __shfl_xor(g1, 32); g2 += __shfl_xor(g2, 32); g3 += __shfl_xor(g3, 32);
            LAS float* pw = part + wave * (32 * 40);
#pragma unroll
            for (int q = 0; q < 16; ++q) { const int tr = (q & 3) + 8 * (q >> 2) + 4 * kk; pw[tr * 40 + i] = ae[q]; }
            if (kk == 0) { *(LAS f32x4*)(pw + i * 40 + 32) = (f32x4){g0, g1, g2, g3}; pw[i * 40 + 36] = ss; }
            __syncthreads();
            STAMP(17);
            int tq7 = tid; asm volatile("" : "+v"(tq7));
            for (int idx = tq7; idx < 32 * 37; idx += NWAVES * 64) { const int tk = idx / 37, j = idx - tk * 37; float a = 0.f;
#pragma unroll
                for (int w = 0; w < 8; ++w) a += part[w * (32 * 40) + tk * 40 + j];
                red[tk * 40 + j] = a; }
            __syncthreads();
            if (tid < 32) {
                const int t = t0 + tid; float lg[36];
#pragma unroll
                for (int j = 0; j < 36; ++j) lg[j] = red[tid * 40 + j];
                const float sq = red[tid * 40 + 36];
                const float rs = 1.0f / sqrtf(sq * (1.0f / D) + EPS);
                float gl[4]; int gi = 0; float gm;
#pragma unroll
                for (int j = 0; j < 4; ++j) gl[j] = lg[32 + j] * rs + in[19][j];
                gm = gl[0];
#pragma unroll
                for (int j = 1; j < 4; ++j) if (gl[j] > gm) { gm = gl[j]; gi = j; }
                float gsum = 0.f;
#pragma unroll
                for (int j = 0; j < 4; ++j) gsum += expf(gl[j] - gm);
                const float gp = 1.0f / gsum;
                float el[8];
#pragma unroll
                for (int j = 0; j < 8; ++j) { float v = 0.f;
#pragma unroll
                    for (int q = 0; q < 4; ++q) v = (gi == q) ? lg[q * 8 + j] : v;
                    el[j] = v * rs + in[21][gi * 8 + j]; }
                int j0 = 0; float v0 = el[0];
#pragma unroll
                for (int j = 1; j < 8; ++j) if (el[j] > v0) { v0 = el[j]; j0 = j; }
                int j1 = -1; float v1 = -INFINITY;
#pragma unroll
                for (int j = 0; j < 8; ++j) if (j != j0 && el[j] > v1) { v1 = el[j]; j1 = j; }
                const float e1 = expf(v1 - v0), w0 = gp / (1.0f + e1), w1 = gp * e1 / (1.0f + e1);
                const int ex0 = gi * 8 + j0, ex1 = gi * 8 + j1;
                const unsigned s0 = atomicAdd(ctl + CW_CNT + 64 * ex0, 1u), s1 = atomicAdd(ctl + CW_CNT + 64 * ex1, 1u);
                int row0 = ex0 * CAP + (int)s0, row1 = ex1 * CAP + (int)s1;
                if (s0 >= (unsigned)CAP) { const unsigned ix = atomicAdd(ctl + CW_OVF, 1u); ((int4*)(ws + WS_OVF))[ix] = make_int4(t, ex0, 0, 0); row0 = -1; }
                if (s1 >= (unsigned)CAP) { const unsigned ix = atomicAdd(ctl + CW_OVF, 1u); ((int4*)(ws + WS_OVF))[ix] = make_int4(t, ex1, 1, 0); row1 = -1; }
                ((int2*)(ws + WS_TOKROW))[t] = make_int2(row0, row1);
                ((f32x4*)(ws + WS_ROUTF))[t] = (f32x4){w0, w1, rs, 0.f};
                sinfo[tid] = (f32x4){__int_as_float(row0), __int_as_float(row1), rs, 0.f};
            }
            __syncthreads();
            STAMP(18);
#pragma unroll 4
            for (int q = 0; q < 4; ++q) {
                const int tl_ = wave * 4 + q; const f32x4 si = sinfo[tl_]; const int row0 = __float_as_int(si.x), row1 = __float_as_int(si.y); const float rs = si.z;
                const f32x4* xr2 = (const f32x4*)(X1 + (size_t)(t0 + tl_) * D) + lane; const f32x4* gr = (const f32x4*)in[17] + lane;
                u32x2* o0 = (u32x2*)((h16*)(ws + WS_XS) + (size_t)(row0 < 0 ? 0 : row0) * D) + lane; u32x2* o1 = (u32x2*)((h16*)(ws + WS_XS) + (size_t)(row1 < 0 ? 0 : row1) * D) + lane;
                f32x4 vv[8];
#pragma unroll
                for (int j = 0; j < 8; ++j) vv[j] = xr2[64 * j];
#pragma unroll
                for (int j = 0; j < 8; ++j) { const f32x4 v = vv[j], gn = gr[64 * j]; u32x2 w; w.x = pk2(v.x * rs * gn.x, v.y * rs * gn.y); w.y = pk2(v.z * rs * gn.z, v.w * rs * gn.w);
                    if (row0 >= 0) o0[64 * j] = w; if (row1 >= 0) o1[64 * j] = w; }
            }
            __syncthreads();
            STAMP(19);
        }
    }
    if (IN(7) && IN(9)) xcd_barrier(bar);
    STAMP(8); STAMP(9);


    LAS int* tlist = (LAS int*)(F.lds + LDSCTL_OFF + 1024);
    if (IN(9) || IN(10)) {
        int tq = tid; asm volatile("" : "+v"(tq));
        if (tq < NE) tlist[128 + tq] = (int)xb_ld(ctl + CW_CNT + 64 * tq);
        __syncthreads();
        if (tid == 0) {
            int nt_ = 0;
            for (int x = 0; x < 8; ++x) { tlist[x] = nt_;
                for (int pass = 0; pass < 2; ++pass)
                    for (int e = x; e < NE; e += 8) { int c = tlist[128 + e]; c = c > CAP ? CAP : c;
                        for (int j = 0; j < CAPT; ++j) { const int rows = c - 256 * j; const bool full = rows > 128, half = rows > 0 && rows <= 128;
                            if (pass == 0 ? full : half) { tlist[16 + nt_] = (e * CAPT + j) | (pass << 16); ++nt_; } } }
                tlist[8 + x] = nt_ - tlist[x]; }
        }
        __syncthreads();
    }
    STAMP(20);
    if (IN(9)) for (int rep_ = 0; rep_ < REPS(9); ++rep_) {
        {
            const int novf = (int)xb_ld(ctl + CW_OVF);
            int tv = tid; asm volatile("" : "+v"(tv));
            LAS float* hrow = (LAS float*)F.lds; LAS float* hidv = hrow + D;
            for (int ix = blockIdx.x; ix < novf && rep_ == 0; ix += F.G) {
                const int4 en = ((const int4*)(ws + WS_OVF))[ix]; const f32x4 rf = ((const f32x4*)(ws + WS_ROUTF))[en.x];
                const float* xr = (const float*)(ws + WS_X1) + (size_t)en.x * D;
                for (int k = tv; k < D; k += NWAVES * 64) hrow[k] = (float)(h16)(xr[k] * rf.z * in[17][k]);
                __syncthreads();
                { const h16* wg = (const h16*)(ws + WS_WGU) + ((size_t)en.y * 1024 + tv) * D; const h16* wu = wg + (size_t)512 * D; float ga = 0.f, up = 0.f;
                  for (int k = 0; k < D; ++k) { ga += hrow[k] * (float)wg[k]; up += hrow[k] * (float)wu[k]; }
                  hidv[tv] = (float)(h16)(ga * pg8::sigmoidf_(ga) * up); }
                __syncthreads();
                const float wk = en.z ? rf.y : rf.x;
                for (int c = tv; c < D; c += NWAVES * 64) { const h16* wd = (const h16*)(ws + WS_WDN) + ((size_t)en.y * D + c) * FF; float y = 0.f;
                    for (int k = 0; k < FF; ++k) y += hidv[k] * (float)wd[k];
                    atomicAdd((float*)(ws + WS_X1) + (size_t)en.x * D + c, wk * (float)(h16)y); }
                __syncthreads();
            }
        }
        STAMP(21);
        pg8::Gemm g{(const h16*)(ws + WS_XS), (const h16*)(ws + WS_WGU), D, (size_t)512 * D * 2};
        pg8::ExpertOrder S{tlist, 4, F.G, (int)blockIdx.x, (size_t)1024 * D * 2, (size_t)pg8::HALF * D * 2};
        pg8::EpiGateUp E{(h16*)(ws + WS_HID)};
        pg8::gemm_phase<pg8::EpiGateUp, pg8::ExpertOrder, true, true>(F.lds, g, S, E);
        STAMP(22);
    }
    SEAM(9);

    if (IN(10)) for (int rep_ = 0; rep_ < REPS(10); ++rep_) {
        pg8::Gemm g{(const h16*)(ws + WS_HID), (const h16*)(ws + WS_WDN), FF, (size_t)pg8::HALF * FF * 2};
        pg8::ExpertOrder S{tlist, 8, F.G, (int)blockIdx.x, (size_t)D * FF * 2, (size_t)pg8::BM * FF * 2};
        pg8::EpiDown E{(h16*)(ws + WS_Y)};
        pg8::gemm_phase<pg8::EpiDown, pg8::ExpertOrder, true, true>(F.lds, g, S, E);
    }
    SEAM(10);

    if (TSB >= 0) { xcd_barrier(bar); }
    if (IN(11)) for (int rep_ = 0; rep_ < REPS(11); ++rep_) {
        const float* X1 = (const float*)(ws + WS_X1); const h16* Y = (const h16*)(ws + WS_Y);
        for (int t = F.gw; t < T; t += F.NGW) {
            const int2 tr = ((const int2*)(ws + WS_TOKROW))[t]; const f32x4 rf = ((const f32x4*)(ws + WS_ROUTF))[t];
            const f32x4* xr = (const f32x4*)(X1 + (size_t)t * D) + lane;
            const u32x2* y0 = (const u32x2*)(Y + (size_t)(tr.x < 0 ? 0 : tr.x) * D) + lane; const u32x2* y1 = (const u32x2*)(Y + (size_t)(tr.y < 0 ? 0 : tr.y) * D) + lane;
            const float wa = tr.x < 0 ? 0.f : rf.x, wb = tr.y < 0 ? 0.f : rf.y;
            f32x4 v[8]; float s = 0.f;
#pragma unroll
            for (int j = 0; j < 8; ++j) { const f32x4 a = pg8::h4_to_f4(y0[64 * j]), b = pg8::h4_to_f4(y1[64 * j]); v[j] = (DBG & 4) ? xr[64 * j] : xr[64 * j] + wa * a + wb * b;
                s += (v[j].x * v[j].x + v[j].y * v[j].y) + (v[j].z * v[j].z + v[j].w * v[j].w); }
            const float r = 1.0f / sqrtf(wave_sum(s) * (1.0f / D) + EPS);
            const f32x4* gr = (const f32x4*)in[25] + lane; f32x4* orow = (f32x4*)(args.out + (size_t)t * D) + lane;
#pragma unroll
            for (int j = 0; j < 8; ++j) orow[64 * j] = v[j] * r * gr[64 * j];
            if (TSB >= 0) {
                const float ta = (TSA >= 0) ? (float)(tsw[(TSA >= 0 ? TSA : 0) + 1] - tsw[TSA >= 0 ? TSA : 0]) * 0.01f : 0.f, tb = (float)(tsw[TSB + 1] - tsw[TSB]) * 0.01f;
                const float amp = sqrtf(ta * 1e-6f) * ((lane & 1) ? 1.f : -1.f);
#pragma unroll
                for (int j = 0; j < 8; ++j) { f32x4 o = v[j] * r * gr[64 * j] + amp; if (TSB >= 0 && t == 0 && lane == 0 && j == 0) o.x += 1.0f + tb * 0.02f; orow[64 * j] = o; }
            }
            if (DBGCHK) {
                const unsigned dv = xb_ld(ctl + CW_DBG); const int code = dv ? 100 - (int)dv : 0;
                const float tab[13] = {1.f, 0.f, 0.5f, 2.f, 3.f, 4.f, 6.f, 10.f, 16.f, 30.f, 60.f, 120.f, 250.f};
                float sc = 1.f;
#pragma unroll
                for (int q = 0; q < 13; ++q) sc = (code == q) ? tab[q] : sc;
                if (code == 8) sc = 2.0f + 10.0f * (float)xb_ld(ctl + CW_DBG + 1) / 512.0f + 100.0f * (float)xb_ld(ctl + CW_DBG + 2) / 512.0f;
                const f32x4* x0 = (const f32x4*)(in[0] + (size_t)t * D) + lane; f32x4 xv[8]; float s2 = 0.f;
#pragma unroll
                for (int j = 0; j < 8; ++j) { xv[j] = x0[64 * j]; s2 += (xv[j].x * xv[j].x + xv[j].y * xv[j].y) + (xv[j].z * xv[j].z + xv[j].w * xv[j].w); }
                const float r2 = 1.0f / sqrtf(wave_sum(s2) * (1.0f / D) + EPS);
#pragma unroll
                for (int j = 0; j < 8; ++j) orow[64 * j] = xv[j] * (r2 * sc) * gr[64 * j];
            }
        }
    }
#undef IN
#undef SEAM
}

extern "C" void kernel_launch(void* const* d_in, const int* in_sizes, int n_in, void* d_out, int out_size, void* d_ws, size_t ws_size, hipStream_t stream) {
    static int grid = 0;
    if (grid == 0) {
        if (n_in != 26 || in_sizes[0] != T * D || out_size != T * D || ws_size < WS_END) { fprintf(stderr, "kernel_launch: unexpected shapes (n_in %d, in0 %d, out %d, ws %zu); nothing launched\n", n_in, n_in > 0 ? in_sizes[0] : -1, out_size, ws_size); grid = -1; return; }
        int dev = 0, cus = 0, per_cu = 0;
        if (hipGetDevice(&dev) != hipSuccess || hipDeviceGetAttribute(&cus, hipDeviceAttributeMultiprocessorCount, dev) != hipSuccess) { fprintf(stderr, "kernel_launch: device query failed\n"); grid = -1; return; }
        if (hipFuncSetAttribute((const void*)fwd_kernel, hipFuncAttributeMaxDynamicSharedMemorySize, LDS_BYTES) != hipSuccess) { fprintf(stderr, "kernel_launch: hipFuncSetAttribute failed\n"); grid = -1; return; }
        if (hipOccupancyMaxActiveBlocksPerMultiprocessor(&per_cu, (const void*)fwd_kernel, NWAVES * 64, LDS_BYTES) != hipSuccess || per_cu < 1) { fprintf(stderr, "kernel_launch: occupancy query reports %d workgroups per CU\n", per_cu); per_cu = 1; }
        (void)hipGetLastError();
        grid = cus;
    }
    if (grid < 0) return;
    if (hipMemsetAsync((char*)d_ws + WS_CTL, 0, CTL_ZERO_BYTES, stream) != hipSuccess) { fprintf(stderr, "kernel_launch: hipMemsetAsync failed\n"); return; }
    Args a{};
    for (int i = 0; i < 26; ++i) a.in[i] = (const float*)d_in[i];
    a.out = (float*)d_out; a.ws = (unsigned char*)d_ws;
    for (int li = 0; li < MK_N_LAUNCHES; ++li) {
        if (MK_N_LAUNCHES == 1) { a.ph_lo = 0; a.ph_hi = 12; } else { a.ph_lo = li; a.ph_hi = li + 1; }
        hipLaunchKernelGGL(fwd_kernel, dim3(grid), dim3(NWAVES * 64), LDS_BYTES, stream, a);
        const hipError_t le = hipPeekAtLastError();
        if (le != hipSuccess) { fprintf(stderr, "kernel_launch: launch %d failed: %s\n", li, hipGetErrorName(le)); break; }
        if (DBGCHK && MK_N_LAUNCHES > 1 && li <= 6) { Args c = a; c.ph_lo = 0; c.ph_hi = 0; c.chk = li + 1; hipLaunchKernelGGL(fwd_kernel, dim3(8), dim3(NWAVES * 64), LDS_BYTES, stream, c); }
    }
}
```
